# Optimizing an MI355X kernel written in HIP

```python
import math
import jax, jax.numpy as jnp
from jax import lax
import numpy as np

D_MODEL = 1024
BATCH = 16
SEQ = 4096
DEPTH = 1

ATT_HEADS = 16
ATT_KV_HEADS = 2
ATT_HEAD_DIM = 64
WINDOW = 128
ROPE_DIM = ATT_HEAD_DIM // 4
ROPE_THETA = 500000.0
ML_HEADS = 8
ML_QK_DIM = 64
ML_V_DIM = 128
ML_CHUNK = 64
GATE_CAP = 15.0
PEER_HEADS = 8
PEER_KEY_DIM = 128
N_KEYS = 128
N_EXPERTS = N_KEYS * N_KEYS
PEER_TOPK = 16
PEER_TOKEN_BLOCK = 128
EPS = 1e-6

ATT_Q_W = ATT_HEADS * ATT_HEAD_DIM
ATT_KV_W = ATT_KV_HEADS * ATT_HEAD_DIM
ML_QK_W = ML_HEADS * ML_QK_DIM
ML_V_W = ML_HEADS * ML_V_DIM
IN_SPLITS = (ATT_Q_W, ATT_KV_W, ATT_KV_W, ML_QK_W, ML_QK_W, ML_V_W, ML_HEADS, ML_HEADS, ML_V_W, D_MODEL, D_MODEL)
IN_WIDTH = ATT_Q_W + 2 * ATT_KV_W + 2 * ML_QK_W + 2 * ML_V_W + 2 * ML_HEADS + 2 * D_MODEL

kernel_name = "hybrid_mlstm_swa_sink_peer"


def rmsnorm(x, gain):
    xf = x.astype(jnp.float32)
    r = lax.rsqrt(jnp.mean(xf * xf, axis=-1, keepdims=True) + EPS)
    return (xf * r * gain.astype(jnp.float32)).astype(x.dtype)


def partial_rope(x, positions):
    half = ROPE_DIM // 2
    inv_freq = ROPE_THETA ** (-jnp.arange(0, ROPE_DIM, 2, dtype=jnp.float32) / ROPE_DIM)
    ang = positions.astype(jnp.float32)[..., None] * inv_freq
    cos = jnp.cos(ang)[:, :, None, :]
    sin = jnp.sin(ang)[:, :, None, :]
    xf = x.astype(jnp.float32)
    x1 = xf[..., :half]
    x2 = xf[..., half:ROPE_DIM]
    rot = jnp.concatenate([x1 * cos - x2 * sin, x2 * cos + x1 * sin], axis=-1)
    return jnp.concatenate([rot, xf[..., ROPE_DIM:]], axis=-1).astype(x.dtype)


def sliding_window_attention(q, k, v, sinks):
    B, S = q.shape[0], q.shape[1]
    nb = S // WINDOW
    G = ATT_HEADS // ATT_KV_HEADS
    qb = q.reshape(B, nb, WINDOW, ATT_KV_HEADS, G, ATT_HEAD_DIM)
    kb = k.reshape(B, nb, WINDOW, ATT_KV_HEADS, ATT_HEAD_DIM)
    vb = v.reshape(B, nb, WINDOW, ATT_KV_HEADS, ATT_HEAD_DIM)

    def with_prev(t):
        prev = jnp.pad(t, ((0, 0), (1, 0), (0, 0), (0, 0), (0, 0)))[:, :-1]
        return jnp.concatenate([prev, t], axis=2)

    kband = with_prev(kb)
    vband = with_prev(vb)
    a_idx = jnp.arange(WINDOW)[:, None]
    c_idx = jnp.arange(2 * WINDOW)[None, :]
    band = (c_idx > a_idx) & (c_idx <= a_idx + WINDOW)
    sink = sinks.astype(jnp.float32).reshape(ATT_KV_HEADS, G)[None, :, :, None, None]
    scale = ATT_HEAD_DIM ** -0.5

    def one_block(args):
        qj, kj, vj, j = args
        s = jnp.einsum('bqhgd,bkhd->bhgqk', qj, kj).astype(jnp.float32) * scale
        valid = band & ((j * WINDOW + c_idx - WINDOW) >= 0)
        s = jnp.where(valid, s, -jnp.inf)
        m = jnp.maximum(jnp.max(s, axis=-1, keepdims=True), sink)
        p = jnp.exp(s - m)
        denom = jnp.sum(p, axis=-1, keepdims=True) + jnp.exp(sink - m)
        return jnp.einsum('bhgqk,bkhd->bqhgd', (p / denom).astype(vj.dtype), vj)

    xs = (jnp.moveaxis(qb, 1, 0), jnp.moveaxis(kband, 1, 0), jnp.moveaxis(vband, 1, 0),
          jnp.arange(nb, dtype=jnp.int32))
    out = lax.map(one_block, xs)
    return jnp.moveaxis(out, 0, 1).reshape(B, S, ATT_Q_W)


def mlstm_chunkwise(q, k, v, i_pre, f_pre):
    B, S, H = q.shape[0], q.shape[1], q.shape[2]
    L = ML_CHUNK
    nc = S // L
    f32 = jnp.float32
    qc = q.astype(f32).reshape(B, nc, L, H, ML_QK_DIM).transpose(1, 0, 3, 2, 4)
    kc = (k.astype(f32) * (ML_QK_DIM ** -0.5)).reshape(B, nc, L, H, ML_QK_DIM).transpose(1, 0, 3, 2, 4)
    vc = v.astype(f32).reshape(B, nc, L, H, ML_V_DIM).transpose(1, 0, 3, 2, 4)
    ic = i_pre.reshape(B, nc, L, H).transpose(1, 0, 3, 2)
    lfc = jax.nn.log_sigmoid(f_pre).reshape(B, nc, L, H).transpose(1, 0, 3, 2)
    causal = jnp.tril(jnp.ones((L, L), dtype=bool))

    def step(carry, xs):
        C, n, m = carry
        qj, kj, vj, ij, lfj = xs
        b = jnp.cumsum(lfj, axis=-1)
        dmat = jnp.where(causal, b[..., :, None] - b[..., None, :] + ij[..., None, :], -jnp.inf)
        inter = b + m[..., None]
        m_t = jnp.maximum(inter, jnp.max(dmat, axis=-1))
        w_intra = jnp.exp(dmat - m_t[..., None])
        w_inter = jnp.exp(inter - m_t)
        qk = jnp.einsum('bhtd,bhsd->bhts', qj, kj) * w_intra
        num = jnp.einsum('bhts,bhsv->bhtv', qk, vj) + w_inter[..., None] * jnp.einsum('bhvd,bhtd->bhtv', C, qj)
        den = jnp.sum(qk, axis=-1) + w_inter * jnp.einsum('bhd,bhtd->bht', n, qj)
        h = num / jnp.maximum(jnp.abs(den), jnp.exp(-m_t))[..., None]
        b_last = b[..., -1]
        g = b_last[..., None] - b + ij
        m_new = jnp.maximum(b_last + m, jnp.max(g, axis=-1))
        w_s = jnp.exp(g - m_new[..., None])
        decay = jnp.exp(b_last + m - m_new)
        C_new = decay[..., None, None] * C + jnp.einsum('bhs,bhsv,bhsd->bhvd', w_s, vj, kj)
        n_new = decay[..., None] * n + jnp.einsum('bhs,bhsd->bhd', w_s, kj)
        return (C_new, n_new, m_new), h

    init = (jnp.zeros((B, H, ML_V_DIM, ML_QK_DIM), f32), jnp.zeros((B, H, ML_QK_DIM), f32),
            jnp.zeros((B, H), f32))
    _, h = lax.scan(step, init, (qc, kc, vc, ic, lfc))
    return h.transpose(1, 0, 3, 2, 4).reshape(B, S, H, ML_V_DIM).astype(q.dtype)


def peer_ffn(x, w_query, sub_keys, expert_down, expert_up):
    B, S, D = x.shape
    xt = x.reshape((B * S) // PEER_TOKEN_BLOCK, PEER_TOKEN_BLOCK, D)
    K = PEER_TOPK

    def one_block(xb):
        t = xb.shape[0]
        q = (xb @ w_query).reshape(t, PEER_HEADS, 2, PEER_KEY_DIM // 2)
        s = jnp.einsum('thpd,hpkd->thpk', q, sub_keys).astype(jnp.float32)
        top_s, top_i = lax.top_k(s, K)
        cand_s = (top_s[:, :, 0, :, None] + top_s[:, :, 1, None, :]).reshape(t, PEER_HEADS, K * K)
        cand_i = (top_i[:, :, 0, :, None] * N_KEYS + top_i[:, :, 1, None, :]).reshape(t, PEER_HEADS, K * K)
        best_s, best_pos = lax.top_k(cand_s, K)
        idx = jnp.take_along_axis(cand_i, best_pos, axis=-1)
        gate = jax.nn.softmax(best_s, axis=-1)
        u = expert_down[idx]
        act = jax.nn.gelu(jnp.einsum('td,thkd->thk', xb, u).astype(jnp.float32), approximate=False)
        vv = expert_up[idx]
        return jnp.einsum('thk,thkd->td', (gate * act).astype(xb.dtype), vv)

    return lax.map(one_block, xt).reshape(B, S, D)


def split_columns(proj):
    offs = np.cumsum(np.array(IN_SPLITS))[:-1].tolist()
    return jnp.split(proj, offs, axis=-1)


def setup_inputs(seed: int = 0) -> dict:
    key = jax.random.key(seed)
    ks = jax.random.split(key, 20)
    f32 = jnp.float32
    nrm = lambda k, shape, s: jax.random.normal(k, shape, f32) * s
    x = jax.random.normal(ks[0], (BATCH, SEQ, D_MODEL), f32)
    offset = jax.random.randint(ks[1], (BATCH, 1), 0, 1024, dtype=jnp.int32)
    positions = offset + jnp.arange(SEQ, dtype=jnp.int32)[None, :]
    return {
        "x": x,
        "positions": positions,
        "norm1_gain": 1.0 + nrm(ks[2], (DEPTH, D_MODEL), 0.02),
        "w_in": nrm(ks[3], (DEPTH, D_MODEL, IN_WIDTH), D_MODEL ** -0.5),
        "ml_i_bias": nrm(ks[4], (DEPTH, ML_HEADS), 0.1),
        "ml_f_bias": jnp.linspace(3.0, 6.0, ML_HEADS, dtype=f32)[None, :] + nrm(ks[5], (DEPTH, ML_HEADS), 0.1),
        "q_norm_gain": 1.0 + nrm(ks[6], (DEPTH, ATT_HEAD_DIM), 0.02),
        "k_norm_gain": 1.0 + nrm(ks[7], (DEPTH, ATT_HEAD_DIM), 0.02),
        "attn_sinks": nrm(ks[8], (DEPTH, ATT_HEADS), 0.5),
        "ml_out_norm_gain": 1.0 + nrm(ks[9], (DEPTH, ML_V_W), 0.02),
        "w_branch_attn": nrm(ks[10], (DEPTH, ATT_Q_W, D_MODEL), ATT_Q_W ** -0.5),
        "w_branch_mlstm": nrm(ks[11], (DEPTH, ML_V_W, D_MODEL), ML_V_W ** -0.5),
        "w_out": nrm(ks[12], (DEPTH, D_MODEL, D_MODEL), D_MODEL ** -0.5),
        "norm2_gain": 1.0 + nrm(ks[13], (DEPTH, D_MODEL), 0.02),
        "peer_w_query": nrm(ks[14], (DEPTH, D_MODEL, PEER_HEADS * PEER_KEY_DIM), D_MODEL ** -0.5),
        "peer_sub_keys": nrm(ks[15], (DEPTH, PEER_HEADS, 2, N_KEYS, PEER_KEY_DIM // 2), (PEER_KEY_DIM // 2) ** -0.5),
        "peer_down": nrm(ks[16], (DEPTH, N_EXPERTS, D_MODEL), D_MODEL ** -0.5),
        "peer_up": nrm(ks[17], (DEPTH, N_EXPERTS, D_MODEL), PEER_HEADS ** -0.5),
    }


def reference(x, positions, norm1_gain, w_in, ml_i_bias, ml_f_bias, q_norm_gain, k_norm_gain,
              attn_sinks, ml_out_norm_gain, w_branch_attn, w_branch_mlstm, w_out, norm2_gain,
              peer_w_query, peer_sub_keys, peer_down, peer_up):
    B, S, _ = x.shape
    for l in range(DEPTH):
        h = rmsnorm(x, norm1_gain[l])
        (aq, ak, av, mq, mk, mv, mi, mf, mo, gate_a, gate_m) = split_columns(h @ w_in[l])
        aq = partial_rope(rmsnorm(aq.reshape(B, S, ATT_HEADS, ATT_HEAD_DIM), q_norm_gain[l]), positions)
        ak = partial_rope(rmsnorm(ak.reshape(B, S, ATT_KV_HEADS, ATT_HEAD_DIM), k_norm_gain[l]), positions)
        av = av.reshape(B, S, ATT_KV_HEADS, ATT_HEAD_DIM)
        att = sliding_window_attention(aq, ak, av, attn_sinks[l])
        att_b = att @ w_branch_attn[l]
        i_pre = mi.astype(jnp.float32) + ml_i_bias[l].astype(jnp.float32)
        f_pre = mf.astype(jnp.float32) + ml_f_bias[l].astype(jnp.float32)
        i_pre = GATE_CAP * jnp.tanh(i_pre / GATE_CAP)
        f_pre = GATE_CAP * jnp.tanh(f_pre / GATE_CAP)
        hm = mlstm_chunkwise(mq.reshape(B, S, ML_HEADS, ML_QK_DIM), mk.reshape(B, S, ML_HEADS, ML_QK_DIM),
                             mv.reshape(B, S, ML_HEADS, ML_V_DIM), i_pre, f_pre)
        hm = rmsnorm(hm, ml_out_norm_gain[l].reshape(ML_HEADS, ML_V_DIM)).reshape(B, S, ML_V_W)
        hm = hm * jax.nn.sigmoid(mo)
        ml_b = hm @ w_branch_mlstm[l]
        mixed = jax.nn.sigmoid(gate_a) * att_b + jax.nn.sigmoid(gate_m) * ml_b
        x = x + mixed @ w_out[l]
        x = x + peer_ffn(rmsnorm(x, norm2_gain[l]), peer_w_query[l], peer_sub_keys[l], peer_down[l], peer_up[l])
    return x
```

```cpp
#include <hip/hip_runtime.h>
#include <cstdint>
#include <cstdio>

namespace {
constexpr int D = 1024, BATCH = 16, SEQ = 4096, M = BATCH * SEQ;
constexpr int AH = 16, AKV = 2, AD = 64, WIN = 128, ROPE = 16;
constexpr int MH = 8, MQK = 64, MV = 128;
constexpr float GATE_CAP = 15.0f;
constexpr int PH = 8, PKD = 128, NKEYS = 128, TOPK = 16;
constexpr float EPS = 1e-6f;
constexpr int INW = 6416;
constexpr int O_AQ = 0, O_AK = 1024, O_AV = 1152, O_MQ = 1280, O_MK = 1792, O_MV = 2304, O_MI = 3328, O_MF = 3336, O_MO = 3344, O_GA = 4368, O_GM = 5392;
constexpr int MC = 16384;

__device__ __forceinline__ float wave_sum(float v) {
#pragma unroll
    for (int o = 1; o < 64; o <<= 1) v += __shfl_xor(v, o);
    return v;
}
__device__ __forceinline__ float wave_max(float v) {
#pragma unroll
    for (int o = 1; o < 64; o <<= 1) v = fmaxf(v, __shfl_xor(v, o));
    return v;
}
__device__ __forceinline__ float sigmoidf_(float x) { return 1.0f / (1.0f + __expf(-x)); }

__global__ void __launch_bounds__(256) k_rmsnorm(const float* __restrict__ x, const float* __restrict__ g, float* __restrict__ y, int rows) {
    const int row = blockIdx.x * 4 + (threadIdx.x >> 6), lane = threadIdx.x & 63;
    if (row >= rows) return;
    const float4* xr = (const float4*)(x + (size_t)row * D);
    float4 v[4]; float s = 0.f;
#pragma unroll
    for (int j = 0; j < 4; ++j) { v[j] = xr[lane + 64 * j]; s += v[j].x * v[j].x + v[j].y * v[j].y + v[j].z * v[j].z + v[j].w * v[j].w; }
    s = wave_sum(s);
    const float r = rsqrtf(s * (1.0f / D) + EPS);
    const float4* gr = (const float4*)g; float4* yr = (float4*)(y + (size_t)row * D);
#pragma unroll
    for (int j = 0; j < 4; ++j) { const float4 gg = gr[lane + 64 * j]; float4 o; o.x = v[j].x * r * gg.x; o.y = v[j].y * r * gg.y; o.z = v[j].z * r * gg.z; o.w = v[j].w * r * gg.w; yr[lane + 64 * j] = o; }
}

template <int MODE>
__global__ void __launch_bounds__(256) k_sgemm(const float* __restrict__ A, const float* __restrict__ B, float* __restrict__ C, const float* __restrict__ R, int Mr, int N, int K, int lda, int ldc) {
    __shared__ float As[16][64 + 4];
    __shared__ float Bs[16][64 + 4];
    const int tx = threadIdx.x & 15, ty = threadIdx.x >> 4;
    const int m0 = blockIdx.y * 64, n0 = blockIdx.x * 64;
    float acc[4][4] = {};
    for (int k0 = 0; k0 < K; k0 += 16) {
        {
            const int r = threadIdx.x >> 2, c = (threadIdx.x & 3) * 4;
            const float4 a = *(const float4*)(A + (size_t)(m0 + r) * lda + k0 + c);
            As[c + 0][r] = a.x; As[c + 1][r] = a.y; As[c + 2][r] = a.z; As[c + 3][r] = a.w;
            const int br = threadIdx.x >> 4, bc = (threadIdx.x & 15) * 4;
            float4 b = {0.f, 0.f, 0.f, 0.f};
            if (n0 + bc < N) b = *(const float4*)(B + (size_t)(k0 + br) * N + n0 + bc);
            Bs[br][bc + 0] = b.x; Bs[br][bc + 1] = b.y; Bs[br][bc + 2] = b.z; Bs[br][bc + 3] = b.w;
        }
        __syncthreads();
#pragma unroll
        for (int kk = 0; kk < 16; ++kk) {
            float a[4], b[4];
#pragma unroll
            for (int i = 0; i < 4; ++i) a[i] = As[kk][ty * 4 + i];
#pragma unroll
            for (int j = 0; j < 4; ++j) b[j] = Bs[kk][tx * 4 + j];
#pragma unroll
            for (int i = 0; i < 4; ++i)
#pragma unroll
                for (int j = 0; j < 4; ++j) acc[i][j] += a[i] * b[j];
        }
        __syncthreads();
    }
    if (n0 + tx * 4 < N) {
#pragma unroll
        for (int i = 0; i < 4; ++i) {
            const size_t off = (size_t)(m0 + ty * 4 + i) * ldc + n0 + tx * 4;
            float4 o = {acc[i][0], acc[i][1], acc[i][2], acc[i][3]};
            if (MODE == 1) { const float4 r = *(const float4*)(R + off); o.x += r.x; o.y += r.y; o.z += r.z; o.w += r.w; }
            *(float4*)(C + off) = o;
        }
    }
}

__global__ void __launch_bounds__(256) k_qknorm_rope(float* __restrict__ proj, const int* __restrict__ pos, const float* __restrict__ qg, const float* __restrict__ kg, int rows) {
    const int wid = blockIdx.x * 4 + (threadIdx.x >> 6), lane = threadIdx.x & 63;
    const int t = wid / 18, hs = wid % 18;
    if (t >= rows) return;
    float* p = proj + (size_t)t * INW + (hs < 16 ? O_AQ + hs * 64 : O_AK + (hs - 16) * 64);
    const float v = p[lane];
    const float ss = wave_sum(v * v);
    const float r = rsqrtf(ss * (1.0f / 64.0f) + EPS);
    const float y = v * r * (hs < 16 ? qg[lane] : kg[lane]);
    const float partner = __shfl_xor(y, 8);
    float o = y;
    if (lane < 16) {
        const int i = lane & 7;
        const float inv_freq = powf(500000.0f, -(float)(2 * i) / 16.0f);
        const float ang = (float)pos[t] * inv_freq;
        float sn, cs; sn = sinf(ang); cs = cosf(ang);
        o = (lane < 8) ? (y * cs - partner * sn) : (y * cs + partner * sn);
    }
    p[lane] = o;
}

__global__ void __launch_bounds__(256) k_attn(const float* __restrict__ proj, const float* __restrict__ sinks, float* __restrict__ att, int rows) {
    const int wid = blockIdx.x * 4 + (threadIdx.x >> 6), lane = threadIdx.x & 63;
    const int t = wid >> 4, h = wid & 15;
    if (t >= rows) return;
    const int kvh = h >> 3;
    const int s_in_seq = t & (SEQ - 1);
    const float* q = proj + (size_t)t * INW + O_AQ + h * 64;
    float sc[2];
#pragma unroll
    for (int u = 0; u < 2; ++u) {
        const int back = lane + 64 * u;
        float s = -INFINITY;
        if (back <= s_in_seq) {
            const float* k = proj + (size_t)(t - back) * INW + O_AK + kvh * 64;
            float a = 0.f;
            for (int d = 0; d < 64; ++d) a += q[d] * k[d];
            s = a * 0.125f;
        }
        sc[u] = s;
    }
    const float sink = sinks[h];
    const float m = fmaxf(wave_max(fmaxf(sc[0], sc[1])), sink);
    const float p0 = __expf(sc[0] - m), p1 = __expf(sc[1] - m);
    const float denom = wave_sum(p0 + p1) + __expf(sink - m);
    float o = 0.f;
    for (int back = 0; back < 128; ++back) {
        if (back > s_in_seq) break;
        const float p = __shfl(back < 64 ? p0 : p1, back & 63);
        o += p * proj[(size_t)(t - back) * INW + O_AV + kvh * 64 + lane];
    }
    att[(size_t)t * D + h * 64 + lane] = o / denom;
}

__global__ void __launch_bounds__(256) k_mlstm(const float* __restrict__ proj, const float* __restrict__ ib, const float* __restrict__ fb, float* __restrict__ hm) {
    const int bs = blockIdx.x / MH, h = blockIdx.x % MH;
    const int tid = threadIdx.x, v = tid >> 1, dh = tid & 1;
    __shared__ float sq[64], sk[64], sv[128], sg[4];
    float C[32];
#pragma unroll
    for (int i = 0; i < 32; ++i) C[i] = 0.f;
    float n = 0.f;
    float m = 0.f;
    const float bi = ib[h], bf = fb[h];
    for (int s = 0; s < SEQ; ++s) {
        const float* pr = proj + (size_t)(bs * SEQ + s) * INW;
        __syncthreads();
        if (tid < 64) { sq[tid] = pr[O_MQ + h * 64 + tid]; sk[tid] = pr[O_MK + h * 64 + tid] * 0.125f; }
        else if (tid < 192) sv[tid - 64] = pr[O_MV + h * 128 + tid - 64];
        else if (tid == 192) {
            float ip = pr[O_MI + h] + bi, fp = pr[O_MF + h] + bf;
            ip = GATE_CAP * tanhf(ip / GATE_CAP); fp = GATE_CAP * tanhf(fp / GATE_CAP);
            const float lf = fminf(fp, 0.f) - log1pf(__expf(-fabsf(fp)));
            sg[0] = ip; sg[1] = lf;
        }
        __syncthreads();
        const float ip = sg[0], lf = sg[1];
        const float m_new = fmaxf(lf + m, ip);
        const float fs = __expf(lf + m - m_new), is = __expf(ip - m_new);
        m = m_new;
        const float vv = sv[v] * is;
        float num = 0.f;
#pragma unroll
        for (int i = 0; i < 32; ++i) { const int d = dh * 32 + i; C[i] = fs * C[i] + vv * sk[d]; num += C[i] * sq[d]; }
        num += __shfl_xor(num, 1);
        float den = 0.f;
        if (tid < 64) { n = fs * n + is * sk[tid]; den = n * sq[tid]; }
        if (tid < 64) { den = wave_sum(den); if (tid == 0) sg[2] = den; }
        __syncthreads();
        den = sg[2];
        const float hv = num / fmaxf(fabsf(den), __expf(-m));
        if (dh == 0) hm[(size_t)(bs * SEQ + s) * D + h * 128 + v] = hv;
    }
}

__global__ void __launch_bounds__(256) k_hmnorm(float* __restrict__ hm, const float* __restrict__ proj, const float* __restrict__ g, int rows) {
    const int wid = blockIdx.x * 4 + (threadIdx.x >> 6), lane = threadIdx.x & 63;
    const int t = wid >> 3, h = wid & 7;
    if (t >= rows) return;
    float* p = hm + (size_t)t * D + h * 128;
    const float a = p[lane], b = p[lane + 64];
    const float r = rsqrtf(wave_sum(a * a + b * b) * (1.0f / 128.0f) + EPS);
    const float* mo = proj + (size_t)t * INW + O_MO + h * 128;
    p[lane] = a * r * g[h * 128 + lane] * sigmoidf_(mo[lane]);
    p[lane + 64] = b * r * g[h * 128 + lane + 64] * sigmoidf_(mo[lane + 64]);
}

__global__ void __launch_bounds__(256) k_mix(float* __restrict__ attb, const float* __restrict__ mlb, const float* __restrict__ proj, int rows) {
    const size_t i = (size_t)blockIdx.x * 256 + threadIdx.x;
    if (i >= (size_t)rows * D) return;
    const int t = (int)(i >> 10), c = (int)(i & 1023);
    const float ga = proj[(size_t)t * INW + O_GA + c], gm = proj[(size_t)t * INW + O_GM + c];
    attb[i] = sigmoidf_(ga) * attb[i] + sigmoidf_(gm) * mlb[i];
}

__global__ void __launch_bounds__(64) k_peer_top1(const float* __restrict__ q, const float* __restrict__ keys, float* __restrict__ tops, int* __restrict__ topi) {
    __shared__ float sc[64][129];
    const int gid = blockIdx.x * 64 + threadIdx.x;
    const int t = gid >> 4, hp = gid & 15;
    const float* qq = q + (size_t)t * D + hp * 64;
    const float* kk = keys + (size_t)hp * 128 * 64;
    float qr[64];
#pragma unroll
    for (int d = 0; d < 64; ++d) qr[d] = qq[d];
    for (int k = 0; k < 128; ++k) {
        float a = 0.f;
#pragma unroll
        for (int d = 0; d < 64; ++d) a += qr[d] * kk[k * 64 + d];
        sc[threadIdx.x][k] = a;
    }
    for (int r = 0; r < 16; ++r) {
        float best = -INFINITY; int bi = 0;
        for (int k = 0; k < 128; ++k) { const float v = sc[threadIdx.x][k]; if (v > best) { best = v; bi = k; } }
        sc[threadIdx.x][bi] = -INFINITY;
        tops[(size_t)gid * 16 + r] = best; topi[(size_t)gid * 16 + r] = bi;
    }
}

__global__ void __launch_bounds__(64) k_peer_top2(const float* __restrict__ tops, const int* __restrict__ topi, int* __restrict__ idx, float* __restrict__ gate) {
    __shared__ float cs[64][257];
    const int gid = blockIdx.x * 64 + threadIdx.x;
    const float* a = tops + (size_t)gid * 32; const float* b = a + 16;
    const int* ia = topi + (size_t)gid * 32; const int* ib = ia + 16;
    for (int i = 0; i < 16; ++i)
        for (int j = 0; j < 16; ++j) cs[threadIdx.x][i * 16 + j] = a[i] + b[j];
    float bs[16]; int bp[16];
#pragma unroll
    for (int r = 0; r < 16; ++r) {
        float best = -INFINITY; int bi = 0;
        for (int k = 0; k < 256; ++k) { const float v = cs[threadIdx.x][k]; if (v > best) { best = v; bi = k; } }
        cs[threadIdx.x][bi] = -INFINITY;
        bs[r] = best; bp[r] = bi;
    }
    float sum = 0.f; const float mx = bs[0];
#pragma unroll
    for (int r = 0; r < 16; ++r) { bs[r] = __expf(bs[r] - mx); sum += bs[r]; }
#pragma unroll
    for (int r = 0; r < 16; ++r) {
        const int i = bp[r] >> 4, j = bp[r] & 15;
        idx[(size_t)gid * 16 + r] = ia[i] * NKEYS + ib[j];
        gate[(size_t)gid * 16 + r] = bs[r] / sum;
    }
}

__global__ void __launch_bounds__(256) k_peer_experts(const float* __restrict__ xn2, const int* __restrict__ idx, const float* __restrict__ gate, const float* __restrict__ down, const float* __restrict__ up, float* __restrict__ out) {
    const int t = blockIdx.x * 4 + (threadIdx.x >> 6), lane = threadIdx.x & 63;
    const float4* xr = (const float4*)(xn2 + (size_t)t * D);
    float4 xv[4], acc[4];
#pragma unroll
    for (int j = 0; j < 4; ++j) { xv[j] = xr[lane + 64 * j]; acc[j] = {0.f, 0.f, 0.f, 0.f}; }
    for (int k = 0; k < 128; ++k) {
        const int e = idx[(size_t)t * 128 + k];
        const float g = gate[(size_t)t * 128 + k];
        const float4* dr = (const float4*)(down + (size_t)e * D);
        float s = 0.f;
#pragma unroll
        for (int j = 0; j < 4; ++j) { const float4 d = dr[lane + 64 * j]; s += xv[j].x * d.x + xv[j].y * d.y + xv[j].z * d.z + xv[j].w * d.w; }
        s = wave_sum(s);
        const float act = 0.5f * s * (1.0f + erff(s * 0.70710678118654752f));
        const float c = g * act;
        const float4* ur = (const float4*)(up + (size_t)e * D);
#pragma unroll
        for (int j = 0; j < 4; ++j) { const float4 u = ur[lane + 64 * j]; acc[j].x += c * u.x; acc[j].y += c * u.y; acc[j].z += c * u.z; acc[j].w += c * u.w; }
    }
    float4* orow = (float4*)(out + (size_t)t * D);
#pragma unroll
    for (int j = 0; j < 4; ++j) { float4 o = orow[lane + 64 * j]; o.x += acc[j].x; o.y += acc[j].y; o.z += acc[j].z; o.w += acc[j].w; orow[lane + 64 * j] = o; }
}
}

extern "C" void kernel_launch(void* const* d_in, const int* in_sizes, int n_in, void* d_out, int out_size, void* d_ws, size_t ws_size, hipStream_t stream) {
    const float* x = (const float*)d_in[0]; const int* pos = (const int*)d_in[1];
    const float* g1 = (const float*)d_in[2]; const float* w_in = (const float*)d_in[3];
    const float* ibias = (const float*)d_in[4]; const float* fbias = (const float*)d_in[5];
    const float* qg = (const float*)d_in[6]; const float* kg = (const float*)d_in[7];
    const float* sinks = (const float*)d_in[8]; const float* mog = (const float*)d_in[9];
    const float* wa = (const float*)d_in[10]; const float* wm = (const float*)d_in[11]; const float* wo = (const float*)d_in[12];
    const float* g2 = (const float*)d_in[13]; const float* wq = (const float*)d_in[14]; const float* skeys = (const float*)d_in[15];
    const float* pdown = (const float*)d_in[16]; const float* pup = (const float*)d_in[17];
    float* out = (float*)d_out;
    char* ws = (char*)d_ws;
    const size_t MiB = 1u << 20;
    float* PROJ = (float*)(ws);
    float* XN = (float*)(ws + 404 * MiB);
    float* ATT = (float*)(ws + 468 * MiB);
    float* HM = (float*)(ws + 532 * MiB);
    float* ATTB = (float*)(ws + 596 * MiB);
    float* MLB = (float*)(ws + 660 * MiB);
    for (int c = 0; c < M / MC; ++c) {
        const float* xc = x + (size_t)c * MC * D; const int* pc = pos + (size_t)c * MC;
        float* oc = out + (size_t)c * MC * D;
        k_rmsnorm<<<MC / 4, 256, 0, stream>>>(xc, g1, XN, MC);
        k_sgemm<0><<<dim3((INW + 63) / 64, MC / 64), 256, 0, stream>>>(XN, w_in, PROJ, nullptr, MC, INW, D, D, INW);
        k_qknorm_rope<<<MC * 18 / 4, 256, 0, stream>>>(PROJ, pc, qg, kg, MC);
        k_attn<<<MC * 16 / 4, 256, 0, stream>>>(PROJ, sinks, ATT, MC);
        k_mlstm<<<(MC / SEQ) * MH, 256, 0, stream>>>(PROJ, ibias, fbias, HM);
        k_hmnorm<<<MC * 8 / 4, 256, 0, stream>>>(HM, PROJ, mog, MC);
        k_sgemm<0><<<dim3(D / 64, MC / 64), 256, 0, stream>>>(ATT, wa, ATTB, nullptr, MC, D, D, D, D);
        k_sgemm<0><<<dim3(D / 64, MC / 64), 256, 0, stream>>>(HM, wm, MLB, nullptr, MC, D, D, D, D);
        k_mix<<<MC * D / 256, 256, 0, stream>>>(ATTB, MLB, PROJ, MC);
        k_sgemm<1><<<dim3(D / 64, MC / 64), 256, 0, stream>>>(ATTB, wo, oc, xc, MC, D, D, D, D);
    }
    float* XN2 = (float*)(ws);
    float* Q = (float*)(ws + 256 * MiB);
    float* TOPS = (float*)(ws + 512 * MiB);
    int* TOPI = (int*)(ws + 576 * MiB);
    int* IDX = (int*)(ws + 640 * MiB);
    float* GATE = (float*)(ws + 672 * MiB);
    k_rmsnorm<<<M / 4, 256, 0, stream>>>(out, g2, XN2, M);
    k_sgemm<0><<<dim3(D / 64, M / 64), 256, 0, stream>>>(XN2, wq, Q, nullptr, M, D, D, D, D);
    k_peer_top1<<<M * 16 / 64, 64, 0, stream>>>(Q, skeys, TOPS, TOPI);
    k_peer_top2<<<M * 8 / 64, 64, 0, stream>>>(TOPS, TOPI, IDX, GATE);
    k_peer_experts<<<M / 4, 256, 0, stream>>>(XN2, IDX, GATE, pdown, pup, out);
}
```

```cpp
#include <hip/hip_runtime.h>
#include <cstdio>
#include <cstdint>
namespace pg8 {
#define PG8_LAS __attribute__((address_space(3)))
typedef unsigned short bf16_t;
typedef short bf16x8 __attribute__((ext_vector_type(8)));
typedef float f32x4 __attribute__((ext_vector_type(4)));
typedef unsigned u32x4 __attribute__((ext_vector_type(4)));
typedef int i32x4 __attribute__((ext_vector_type(4)));
constexpr int BM = 256, BK = 64, HALF = 128, HTB = HALF * BK * 2  , STAGE_BYTES = 8 * HTB, NXCD = 8, WGM = 8;

__host__ __device__ __forceinline__ int lds_byte(int r, int c) { const int st = (r >> 4) * 2 + (c >> 5), rr = r & 15, cc = c & 31, ob = rr * 64 + cc * 2; return st * 1024 + (ob ^ (((ob >> 9) & 1) << 5)); }
__host__ __device__ __forceinline__ void stage_rc(int b, int& R, int& C) { const int st = b / 1024, sb = b % 1024, swz = sb ^ (((sb >> 9) & 1) << 5); R = (st >> 1) * 16 + swz / 64; C = (st & 1) * 32 + (swz % 64) / 2; }
__host__ __device__ __forceinline__ int perm32(int rho) { const int n = rho >> 4, i = rho & 15; return 8 * (i >> 2) + 4 * n + (i & 3); }

struct Unit { int pm, pn; };
struct Gemm { const bf16_t* A; const bf16_t* Bt; int M, N, K, lda; const bf16_t* A2; int lda2, K1; };

struct StaticOrder {
    int nM, nN, nwg, G, c;
    __host__ __device__ void init(int M, int N, int G_, int c_) { nM = M / BM; nN = N / BM; nwg = nM * nN; G = G_; c = c_; }
    __host__ __device__ bool next(int i, Unit& u) const {
        const long L = (long)i * G + c; if (L >= nwg) return false;
        int wgid = (int)L; { const int q = nwg / NXCD, r = nwg % NXCD, xcd = wgid % NXCD, off = wgid / NXCD; wgid = (xcd < r ? xcd * (q + 1) : r * (q + 1) + (xcd - r) * q) + off; }
        const int nig = WGM * nN, gid = wgid / nig, fm = gid * WGM, gsz = (nM - fm) < WGM ? (nM - fm) : WGM;
        u.pm = fm + ((wgid % nig) % gsz); u.pn = (wgid % nig) / gsz; return true;
    }
    __device__ __forceinline__ void a_ready(const Unit&) const {}
    __device__ __forceinline__ void done(const Unit&) const {}
};

__device__ __forceinline__ unsigned cvt_pk_bf16(float lo, float hi) { unsigned r; asm volatile("v_cvt_pk_bf16_f32 %0, %1, %2" : "=v"(r) : "v"(lo), "v"(hi)); return r; }
__device__ __forceinline__ float bf_lo(unsigned w) { return __builtin_bit_cast(float, w << 16); }
__device__ __forceinline__ float bf_hi(unsigned w) { return __builtin_bit_cast(float, w & 0xffff0000u); }
__device__ __forceinline__ float fast_sigmoid(float x) { return __builtin_amdgcn_rcpf(1.0f + __expf(-x)); }
__device__ __forceinline__ void unpack8(const u32x4 w, float (&f)[8]) { f[0] = bf_lo(w.x); f[1] = bf_hi(w.x); f[2] = bf_lo(w.y); f[3] = bf_hi(w.y); f[4] = bf_lo(w.z); f[5] = bf_hi(w.z); f[6] = bf_lo(w.w); f[7] = bf_hi(w.w); }
__device__ __forceinline__ u32x4 pack8(const float (&f)[8]) { u32x4 w; w.x = cvt_pk_bf16(f[0], f[1]); w.y = cvt_pk_bf16(f[2], f[3]); w.z = cvt_pk_bf16(f[4], f[5]); w.w = cvt_pk_bf16(f[6], f[7]); return w; }
constexpr int LDP = 4352;
constexpr int GPM = 65536;
constexpr float MIX_CLIP = 3.2f, MIX_ISCALE = 127.0f / MIX_CLIP;

struct EpiProj {
    static constexpr bool PERM = true, AFTER_DRAIN = false, HAS_PRE = true;
    bf16_t* O; const float* SX; const float* SW;
    unsigned char* GP;
    PG8_LAS unsigned char* L;
    struct Pre {};
    __device__ __forceinline__ void preload(Pre&, const Unit& u, int wid, int lane) const {
        const float* src = (wid < 4) ? SW + u.pn * BM + wid * 64 + lane : SX + u.pm * BM + (wid - 4) * 64 + lane;
        __builtin_amdgcn_global_load_lds((const unsigned*)src, (PG8_LAS unsigned*)(L + wid * 256), 4, 0, 0);
    }
    __device__ __forceinline__ void operator()(const i32x4 (&acc)[2][2][4][2], const Unit& u, int wr, int wc, int fr, int fq, const Pre&) const {
        const int row0 = u.pm * BM + wr * 64 + fr, col0 = u.pn * BM + wc * 32 + 8 * fq;
        const float sc = (u.pn == 7 || u.pn == 8) ? 0.125f : 1.f; const bool sig = u.pn >= 13, gates = u.pn >= 17;
        unsigned char* gbase = GP + (size_t)(u.pn - 17) * ((size_t)GPM * 256) + 16 * (4 * wc + fq);
        float sw[2][8]; f32x4 lw[2][2];
#pragma unroll
        for (int bj = 0; bj < 2; ++bj) { lw[bj][0] = *(const PG8_LAS f32x4*)(L + (wc * 32 + 8 * fq + bj * HALF) * 4); lw[bj][1] = *(const PG8_LAS f32x4*)(L + (wc * 32 + 8 * fq + bj * HALF) * 4 + 16); }
#pragma unroll
        for (int bj = 0; bj < 2; ++bj)
#pragma unroll
            for (int e = 0; e < 4; ++e) { sw[bj][e] = lw[bj][0][e] * (sc * (1.0f / 127.0f)); sw[bj][4 + e] = lw[bj][1][e] * (sc * (1.0f / 127.0f)); }
#pragma unroll
        for (int ai = 0; ai < 2; ++ai) {
#pragma unroll
            for (int m = 0; m < 4; ++m) { bf16_t* rowp = O + (size_t)(row0 + ai * HALF + m * 16) * LDP + col0; const float sxm = *(const PG8_LAS float*)(L + 1024 + (wr * 64 + fr + ai * HALF + m * 16) * 4);
                float f[2][8];
#pragma unroll
                for (int bj = 0; bj < 2; ++bj)
#pragma unroll
                    for (int e = 0; e < 4; ++e) { f[bj][e] = (float)acc[ai][bj][m][0][e] * (sxm * sw[bj][e]); f[bj][4 + e] = (float)acc[ai][bj][m][1][e] * (sxm * sw[bj][4 + e]); }
                if (sig) {
#pragma unroll
                    for (int e = 0; e < 8; ++e) {
                        const float ea = __expf(-f[0][e]), eb = __expf(-f[1][e]);
                        f[0][e] = __builtin_amdgcn_rcpf(1.0f + ea); f[1][e] = __builtin_amdgcn_rcpf(1.0f + eb); }
                }
                if (gates) {
                    unsigned g4[4] = {0u, 0u, 0u, 0u};
#pragma unroll
                    for (int e = 0; e < 4; ++e) { g4[0] = __builtin_amdgcn_cvt_pk_u8_f32(f[0][e] * 255.0f, e, g4[0]); g4[1] = __builtin_amdgcn_cvt_pk_u8_f32(f[0][4 + e] * 255.0f, e, g4[1]);
                                                  g4[2] = __builtin_amdgcn_cvt_pk_u8_f32(f[1][e] * 255.0f, e, g4[2]); g4[3] = __builtin_amdgcn_cvt_pk_u8_f32(f[1][4 + e] * 255.0f, e, g4[3]); }
                    *(u32x4*)(gbase + (size_t)(row0 + ai * HALF + m * 16) * 256) = (u32x4){g4[0], g4[1], g4[2], g4[3]};
                } else if (sig) {
                    unsigned g4[4] = {0u, 0u, 0u, 0u};
#pragma unroll
                    for (int e = 0; e < 4; ++e) { g4[0] = __builtin_amdgcn_cvt_pk_u8_f32(f[0][e] * 255.0f, e, g4[0]); g4[1] = __builtin_amdgcn_cvt_pk_u8_f32(f[0][4 + e] * 255.0f, e, g4[1]);
                                                  g4[2] = __builtin_amdgcn_cvt_pk_u8_f32(f[1][e] * 255.0f, e, g4[2]); g4[3] = __builtin_amdgcn_cvt_pk_u8_f32(f[1][4 + e] * 255.0f, e, g4[3]); }
                    typedef unsigned u32x2w __attribute__((ext_vector_type(2)));
                    unsigned char* mp = (unsigned char*)(O + (size_t)(row0 + ai * HALF + m * 16) * LDP + 3328) + (col0 - 3328);
                    *(u32x2w*)(mp) = (u32x2w){g4[0], g4[1]}; *(u32x2w*)(mp + HALF) = (u32x2w){g4[2], g4[3]};
                } else { *(u32x4*)(rowp) = pack8(f[0]); *(u32x4*)(rowp + HALF) = pack8(f[1]); } }
        }
    }
};
struct EpiX1 {
    static constexpr bool PERM = true, AFTER_DRAIN = false, HAS_PRE = false; struct Pre {};
    const float* X; bf16_t* X1B; float* SSQ; const float* SW;
    __device__ __forceinline__ void operator()(const i32x4 (&acc)[2][2][4][2], const Unit& u, int wr, int wc, int fr, int fq) const {
        const int row0 = u.pm * BM + wr * 64 + fr, col0 = u.pn * BM + wc * 32 + 8 * fq;
        f32x4 sw[2][2];
#pragma unroll
        for (int bj = 0; bj < 2; ++bj)
#pragma unroll
            for (int n = 0; n < 2; ++n) sw[bj][n] = *(const f32x4*)(SW + col0 + bj * HALF + 4 * n) * (MIX_CLIP / (127.0f * 127.0f));
#pragma unroll
        for (int ai = 0; ai < 2; ++ai)
#pragma unroll
          for (int mh = 0; mh < 2; ++mh) {
            f32x4 xv[2][2][2];
#pragma unroll
            for (int m2 = 0; m2 < 2; ++m2)
#pragma unroll
                for (int bj = 0; bj < 2; ++bj) { const size_t off = (size_t)(row0 + ai * HALF + (2 * mh + m2) * 16) * 1024 + col0 + bj * HALF; xv[m2][bj][0] = *(const f32x4*)(X + off); xv[m2][bj][1] = *(const f32x4*)(X + off + 4); }
#pragma unroll
            for (int m2 = 0; m2 < 2; ++m2) { const int m = 2 * mh + m2; const size_t row = (size_t)(row0 + ai * HALF + m * 16); float ss = 0.f;
#pragma unroll
                for (int bj = 0; bj < 2; ++bj) { const size_t off = row * 1024 + col0 + bj * HALF;
                    f32x4 a, b;
#pragma unroll
                    for (int e = 0; e < 4; ++e) { a[e] = xv[m2][bj][0][e] + (float)acc[ai][bj][m][0][e] * sw[bj][0][e]; b[e] = xv[m2][bj][1][e] + (float)acc[ai][bj][m][1][e] * sw[bj][1][e]; }
                    { const float ab[8] = {a[0], a[1], a[2], a[3], b[0], b[1], b[2], b[3]}; *(u32x4*)(X1B + row * LDP + col0 + bj * HALF) = pack8(ab); }
                    ss += (a[0] * a[0] + a[1] * a[1]) + (a[2] * a[2] + a[3] * a[3]) + (b[0] * b[0] + b[1] * b[1]) + (b[2] * b[2] + b[3] * b[3]); }
                ss += __shfl_xor(ss, 16); ss += __shfl_xor(ss, 32);
                if (fq == 0) SSQ[row * 16 + u.pn * 4 + wc] = ss; }
          }
    }
};
struct EpiQ {
    static constexpr bool PERM = true, AFTER_DRAIN = false, HAS_PRE = false; struct Pre {};
    bf16_t* O; const float* XDQ; const float* SW;
    __device__ __forceinline__ void operator()(const i32x4 (&acc)[2][2][4][2], const Unit& u, int wr, int wc, int fr, int fq) const {
        const int row0 = u.pm * BM + wr * 64 + fr, col0 = u.pn * BM + wc * 32 + 8 * fq;
        float sw[2][8];
#pragma unroll
        for (int bj = 0; bj < 2; ++bj) { const f32x4 w0 = *(const f32x4*)(SW + col0 + bj * HALF), w1 = *(const f32x4*)(SW + col0 + bj * HALF + 4);
#pragma unroll
            for (int e = 0; e < 4; ++e) { sw[bj][e] = w0[e] * (1.0f / 127.0f); sw[bj][4 + e] = w1[e] * (1.0f / 127.0f); } }
#pragma unroll
        for (int ai = 0; ai < 2; ++ai) {
            float sx[4];
#pragma unroll
            for (int m = 0; m < 4; ++m) sx[m] = XDQ[row0 + ai * HALF + m * 16];
#pragma unroll
            for (int m = 0; m < 4; ++m) { const size_t row = (size_t)(row0 + ai * HALF + m * 16);
#pragma unroll
                for (int bj = 0; bj < 2; ++bj) { float f[8];
#pragma unroll
                    for (int e = 0; e < 4; ++e) { f[e] = (float)acc[ai][bj][m][0][e] * (sx[m] * sw[bj][e]); f[4 + e] = (float)acc[ai][bj][m][1][e] * (sx[m] * sw[bj][4 + e]); }
                    *(u32x4*)(O + row * LDP + col0 + bj * HALF) = pack8(f); } }
        }
    }
};
struct EpiMixDual {
    static constexpr bool PERM = true, AFTER_DRAIN = false;
    bf16_t* O; const unsigned char* G;
    __device__ __forceinline__ void mid(f32x4 (&acc)[2][2][4][2], const Unit& u, int wr, int wc, int fr, int fq) const {
        const int row0 = u.pm * BM + wr * 64 + fr;
        const unsigned char* g0 = G + ((size_t)(2 * u.pn) * GPM + (size_t)row0) * 256 + 16 * (4 * wc + fq);
#pragma unroll
        for (int bj = 0; bj < 2; ++bj) {
            u32x4 rv[2][4];
#pragma unroll
            for (int ai = 0; ai < 2; ++ai)
#pragma unroll
                for (int m = 0; m < 4; ++m) rv[ai][m] = *(const u32x4*)(g0 + (size_t)bj * ((size_t)GPM * 256) + (ai * HALF + m * 16) * 256);
#pragma unroll
            for (int ai = 0; ai < 2; ++ai)
#pragma unroll
                for (int m = 0; m < 4; ++m) {
                    const unsigned ga[2] = {rv[ai][m].x, rv[ai][m].y}, gm[2] = {rv[ai][m].z, rv[ai][m].w};
#pragma unroll
                    for (int n = 0; n < 2; ++n)
#pragma unroll
                        for (int e = 0; e < 4; ++e) acc[ai][bj][m][n][e] *= (float)((ga[n] >> (8 * e)) & 0xffu) * __builtin_amdgcn_rcpf(fmaxf((float)((gm[n] >> (8 * e)) & 0xffu), 1.0f));
                }
            asm volatile("" ::: "memory");
        }
    }
    __device__ __forceinline__ void operator()(const f32x4 (&acc)[2][2][4][2], const Unit& u, int wr, int wc, int fr, int fq) const {
        const int row0 = u.pm * BM + wr * 64 + fr, col0 = u.pn * BM + wc * 32 + 8 * fq;
        typedef unsigned u32x2v __attribute__((ext_vector_type(2)));
        const unsigned char* g0 = G + ((size_t)(2 * u.pn) * GPM + (size_t)row0) * 256 + 16 * (4 * wc + fq) + 8;
#pragma unroll
        for (int ai = 0; ai < 2; ++ai) {
            u32x2v gv[4][2];
#pragma unroll
            for (int m = 0; m < 4; ++m)
#pragma unroll
                for (int bj = 0; bj < 2; ++bj) gv[m][bj] = *(const u32x2v*)(g0 + (size_t)bj * ((size_t)GPM * 256) + (ai * HALF + m * 16) * 256);
#pragma unroll
            for (int m = 0; m < 4; ++m) { const size_t row = (size_t)(row0 + ai * HALF + m * 16);
#pragma unroll
                for (int bj = 0; bj < 2; ++bj) { unsigned w2[2];
#pragma unroll
                    for (int n = 0; n < 2; ++n) { unsigned a4 = 0u;
#pragma unroll
                        for (int e = 0; e < 4; ++e) { float v = acc[ai][bj][m][n][e] * fmaxf((float)((gv[m][bj][n] >> (8 * e)) & 0xffu), 1.0f) * (MIX_ISCALE / 255.0f); v = fminf(fmaxf(v, -127.f), 127.f); a4 |= (unsigned)((int)__builtin_rintf(v) & 0xff) << (8 * e); }
                        w2[n] = a4; }
                    *(u32x2v*)((unsigned char*)(O + row * LDP) + col0 + bj * HALF) = (u32x2v){w2[0], w2[1]}; } }
        }
    }
};
template <class Epi, class Sched, bool ALIGN_EPI = false, bool SP2 = false>
__device__ __forceinline__ void gemm_phase(PG8_LAS unsigned char* lds, const Gemm g, const Sched& S, const Epi& E) {
    const int tid = threadIdx.x, wid = __builtin_amdgcn_readfirstlane(tid >> 6), lane = tid & 63, wr = wid >> 2, wc = wid & 3, fr = lane & 15, fq = lane >> 4;
    const int K = g.K, nt = K / BK;
    unsigned voffA[2], voffB[2];
#pragma unroll
    for (int i = 0; i < 2; ++i) { int R, C; stage_rc(tid * 16 + i * 8192, R, C); const int Rb = Epi::PERM ? ((R & ~31) + perm32(R & 31)) : R;
        voffA[i] = (unsigned)(R * g.lda + C) * 2u; voffB[i] = (unsigned)(Rb * K + C) * 2u; }
    const size_t kstep = (size_t)(BK * 2);
    const size_t hstepB = (size_t)HALF * K * 2, hstepA = (size_t)HALF * g.lda * 2;
    const size_t tstepA = 2 * hstepA, tstepB = 2 * hstepB;
    const unsigned ldsw = (unsigned)wid * 1024u;
    const int aoff = lds_byte(wr * 64 + fr, fq * 8), boff = lds_byte(wc * 32 + fr, fq * 8);
#define PG8_SA(b, h) (((b) * 2 + (h)) * HTB)
#define PG8_SB(b, h) ((4 + (b) * 2 + (h)) * HTB)
#define PG8_STAGE(bufoff, gbase, voff) do { _Pragma("unroll") for (int _i = 0; _i < 2; ++_i) \
        __builtin_amdgcn_global_load_lds((const unsigned*)((const char*)(gbase) + (voff)[_i]), (PG8_LAS unsigned*)(lds + (bufoff) + ldsw + _i * 8192), 16, 0, 0); } while (0)
#define PG8_LDA(dst, b, h) do { _Pragma("unroll") for (int m = 0; m < 4; ++m) _Pragma("unroll") for (int k = 0; k < 2; ++k) dst[m][k] = *(const PG8_LAS bf16x8*)(lds + PG8_SA(b, h) + aoff + m * 2048 + k * 1024); } while (0)
#define PG8_LDB(dst, b, h) do { _Pragma("unroll") for (int n = 0; n < 2; ++n) _Pragma("unroll") for (int k = 0; k < 2; ++k) dst[n][k] = *(const PG8_LAS bf16x8*)(lds + PG8_SB(b, h) + boff + n * 2048 + k * 1024); } while (0)
#define PG8_MMA(ai, bj, At, Bt) do { __builtin_amdgcn_s_setprio(1); _Pragma("unroll") for (int m = 0; m < 4; ++m) _Pragma("unroll") for (int n = 0; n < 2; ++n) _Pragma("unroll") for (int k = 0; k < 2; ++k) \
        acc[ai][bj][m][n] = __builtin_amdgcn_mfma_f32_16x16x32_bf16(Bt[n][k], At[m][k], acc[ai][bj][m][n], 0, 0, 0); __builtin_amdgcn_s_setprio(0); } while (0)
#define PG8_WAIT_V(n) asm volatile("s_waitcnt vmcnt(" #n ")" ::: "memory")
#define PG8_WAIT_L(n) asm volatile("s_waitcnt lgkmcnt(" #n ")" ::: "memory")
#define PG8_BAR __builtin_amdgcn_s_barrier()
#define PG8_SCHED __builtin_amdgcn_sched_barrier(0)
    Unit cur, nxt; int ui = 0;
    if (!S.next(0, cur)) return;
    f32x4 acc[2][2][4][2];
#pragma unroll
    for (int a = 0; a < 2; ++a)
#pragma unroll
        for (int b = 0; b < 2; ++b)
#pragma unroll
            for (int m = 0; m < 4; ++m)
#pragma unroll
                for (int n = 0; n < 2; ++n) acc[a][b][m][n] = (f32x4){0.f, 0.f, 0.f, 0.f};
    bf16x8 At[4][2], B0[2][2], B1[2][2];
    const char* cA = (const char*)g.A + (size_t)cur.pm * tstepA; const char* cB = (const char*)g.Bt + (size_t)cur.pn * tstepB;
    S.a_ready(cur);
    if constexpr (SP2) {
        PG8_STAGE(PG8_SB(0, 0), cB, voffB); PG8_STAGE(PG8_SB(0, 1), cB + hstepB, voffB); PG8_STAGE(PG8_SA(0, 0), cA, voffA); PG8_STAGE(PG8_SA(0, 1), cA + hstepA, voffA);
        if (wr == 1) PG8_BAR;
        PG8_WAIT_V(2); PG8_BAR;
        PG8_STAGE(PG8_SB(1, 0), cB + kstep, voffB); PG8_STAGE(PG8_SA(1, 0), cA + kstep, voffA); PG8_STAGE(PG8_SB(1, 1), cB + hstepB + kstep, voffB);
        PG8_WAIT_V(6); PG8_BAR;
    } else {
        PG8_STAGE(PG8_SB(0, 0), cB, voffB); PG8_STAGE(PG8_SA(0, 0), cA, voffA); PG8_STAGE(PG8_SB(0, 1), cB + hstepB, voffB); PG8_STAGE(PG8_SA(0, 1), cA + hstepA, voffA);
        if (wr == 1) PG8_BAR;
        PG8_WAIT_V(4); PG8_BAR;
        PG8_STAGE(PG8_SB(1, 0), cB + kstep, voffB); PG8_STAGE(PG8_SA(1, 0), cA + kstep, voffA); PG8_STAGE(PG8_SB(1, 1), cB + hstepB + kstep, voffB);
        PG8_WAIT_V(6); PG8_BAR;
    }
    for (;;) {
        const bool has_next = S.next(ui + 1, nxt);
        const char* nA = has_next ? (const char*)g.A + (size_t)nxt.pm * tstepA : cA; const char* nB = has_next ? (const char*)g.Bt + (size_t)nxt.pn * tstepB : cB;
        for (int t = 0; t < nt; t += 2) {
            const bool last = (t == nt - 2);
            const char* a1 = cA + (size_t)(t + 1) * kstep;
            const char* a2 = last ? nA : cA + (size_t)(t + 2) * kstep; const char* b2 = last ? nB : cB + (size_t)(t + 2) * kstep;
            const char* a3 = a2 + kstep; const char* b3 = b2 + kstep;
            if (last && has_next) S.a_ready(nxt);
            if constexpr (SP2) {
            PG8_LDB(B0, 0, 0); PG8_LDB(B1, 0, 1); PG8_SCHED; PG8_LDA(At, 0, 0); PG8_STAGE(PG8_SA(1, 1), a1 + hstepA, voffA);
            PG8_WAIT_V(8); PG8_WAIT_L(0); PG8_BAR; PG8_MMA(0, 0, At, B0); PG8_MMA(0, 1, At, B1); PG8_BAR; PG8_SCHED;
            PG8_LDA(At, 0, 1); PG8_STAGE(PG8_SB(0, 0), b2, voffB); PG8_STAGE(PG8_SB(0, 1), b2 + hstepB, voffB); PG8_STAGE(PG8_SA(0, 0), a2, voffA);
            PG8_WAIT_V(8); PG8_WAIT_L(0); PG8_BAR; PG8_MMA(1, 0, At, B0); PG8_MMA(1, 1, At, B1); PG8_BAR; PG8_SCHED;
            PG8_LDB(B0, 1, 0); PG8_LDB(B1, 1, 1); PG8_SCHED; PG8_LDA(At, 1, 0); PG8_STAGE(PG8_SA(0, 1), a2 + hstepA, voffA);
            PG8_WAIT_V(8); PG8_WAIT_L(0); PG8_BAR; PG8_MMA(0, 0, At, B0); PG8_MMA(0, 1, At, B1); PG8_BAR; PG8_SCHED;
            PG8_LDA(At, 1, 1); PG8_STAGE(PG8_SB(1, 0), b3, voffB); PG8_STAGE(PG8_SB(1, 1), b3 + hstepB, voffB); PG8_STAGE(PG8_SA(1, 0), a3, voffA);
            PG8_WAIT_V(8); PG8_WAIT_L(0); PG8_BAR; PG8_MMA(1, 0, At, B0); PG8_MMA(1, 1, At, B1); PG8_BAR; PG8_SCHED;
            } else {
            PG8_LDB(B0, 0, 0); PG8_SCHED; PG8_LDA(At, 0, 0); PG8_STAGE(PG8_SA(1, 1), a1 + hstepA, voffA);
            PG8_WAIT_L(8); PG8_BAR; PG8_WAIT_L(0); PG8_MMA(0, 0, At, B0); PG8_BAR; PG8_SCHED;
            PG8_LDB(B1, 0, 1); PG8_STAGE(PG8_SB(0, 0), b2, voffB);
            PG8_BAR; PG8_WAIT_L(0); PG8_MMA(0, 1, At, B1); PG8_BAR;
            PG8_LDA(At, 0, 1); PG8_STAGE(PG8_SA(0, 0), a2, voffA);
            PG8_BAR; PG8_WAIT_L(0); PG8_MMA(1, 0, At, B0); PG8_BAR; PG8_SCHED;
            PG8_STAGE(PG8_SB(0, 1), b2 + hstepB, voffB);
            PG8_WAIT_V(6); PG8_BAR; PG8_MMA(1, 1, At, B1); PG8_BAR;
            PG8_LDB(B0, 1, 0); PG8_SCHED; PG8_LDA(At, 1, 0); PG8_STAGE(PG8_SA(0, 1), a2 + hstepA, voffA);
            PG8_WAIT_L(8); PG8_BAR; PG8_WAIT_L(0); PG8_MMA(0, 0, At, B0); PG8_BAR; PG8_SCHED;
            PG8_LDB(B1, 1, 1); PG8_STAGE(PG8_SB(1, 0), b3, voffB);
            PG8_BAR; PG8_WAIT_L(0); PG8_MMA(0, 1, At, B1); PG8_BAR;
            PG8_LDA(At, 1, 1); PG8_STAGE(PG8_SA(1, 0), a3, voffA);
            PG8_BAR; PG8_WAIT_L(0); PG8_MMA(1, 0, At, B0); PG8_BAR; PG8_SCHED;
            PG8_STAGE(PG8_SB(1, 1), b3 + hstepB, voffB);
            PG8_WAIT_V(6); PG8_BAR; PG8_MMA(1, 1, At, B1); PG8_BAR;
            }
        }
        if constexpr (ALIGN_EPI) { if (wr == 0) PG8_BAR; }
        if constexpr (!Epi::AFTER_DRAIN) { E(acc, cur, wr, wc, fr, fq); S.done(cur); }
        if (!has_next) break;
#pragma unroll
        for (int a = 0; a < 2; ++a)
#pragma unroll
            for (int b = 0; b < 2; ++b)
#pragma unroll
                for (int m = 0; m < 4; ++m)
#pragma unroll
                    for (int n = 0; n < 2; ++n) acc[a][b][m][n] = (f32x4){0.f, 0.f, 0.f, 0.f};
        cur = nxt; cA = nA; cB = nB; ++ui;
        if constexpr (ALIGN_EPI) { if (wr == 1) PG8_BAR; }
    }
    PG8_WAIT_V(0);
    if constexpr (!ALIGN_EPI) { if (wr == 0) PG8_BAR; }
    PG8_BAR;
    if constexpr (Epi::AFTER_DRAIN) { E.fused(acc, cur, wr, wc, fr, fq, lds, wid, lane); S.done(cur); }
#undef PG8_SA
#undef PG8_SB
#undef PG8_STAGE
#undef PG8_LDA
#undef PG8_LDB
#undef PG8_MMA
#undef PG8_WAIT_V
#undef PG8_WAIT_L
#undef PG8_BAR
#undef PG8_SCHED
}
template <class Epi, class Sched, bool ALIGN_EPI = false, bool SP2 = false>
__device__ __forceinline__ void gemm_phase_i8(PG8_LAS unsigned char* lds, const Gemm g, const Sched& S, const Epi& E) {
    const int tid = threadIdx.x, wid = __builtin_amdgcn_readfirstlane(tid >> 6), lane = tid & 63, wr = wid >> 2, wc = wid & 3, fr = lane & 15, fq = lane >> 4;
    const int K = g.K, nt = K / BK;
    unsigned voffA[2], voffB[2];
#pragma unroll
    for (int i = 0; i < 2; ++i) { int R, C; stage_rc(tid * 16 + i * 8192, R, C); const int Rb = Epi::PERM ? ((R & ~31) + perm32(R & 31)) : R;
        voffA[i] = (unsigned)(R * g.lda + C) * 2u; voffB[i] = (unsigned)(Rb * K + C) * 2u; }
    const size_t kstep = (size_t)(BK * 2);
    const size_t hstepB = (size_t)HALF * K * 2, hstepA = (size_t)HALF * g.lda * 2;
    const size_t tstepA = 2 * hstepA, tstepB = 2 * hstepB;
    const unsigned ldsw = (unsigned)wid * 1024u;
    const int aoff = lds_byte(wr * 64 + fr, fq * 8), boff = lds_byte(wc * 32 + fr, fq * 8);
#define PG8_SA(b, h) (((b) * 2 + (h)) * HTB)
#define PG8_SB(b, h) ((4 + (b) * 2 + (h)) * HTB)
#define PG8_STAGE(bufoff, gbase, voff) do { _Pragma("unroll") for (int _i = 0; _i < 2; ++_i) \
        __builtin_amdgcn_global_load_lds((const unsigned*)((const char*)(gbase) + (voff)[_i]), (PG8_LAS unsigned*)(lds + (bufoff) + ldsw + _i * 8192), 16, 0, 0); } while (0)
#define PG8_LDA(dst, b, h) do { _Pragma("unroll") for (int m = 0; m < 4; ++m) _Pragma("unroll") for (int k = 0; k < 2; ++k) dst[m][k] = *(const PG8_LAS bf16x8*)(lds + PG8_SA(b, h) + aoff + m * 2048 + k * 1024); } while (0)
#define PG8_LDB(dst, b, h) do { _Pragma("unroll") for (int n = 0; n < 2; ++n) _Pragma("unroll") for (int k = 0; k < 2; ++k) dst[n][k] = *(const PG8_LAS bf16x8*)(lds + PG8_SB(b, h) + boff + n * 2048 + k * 1024); } while (0)
#define PG8_MMA(ai, bj, At, Bt) do { __builtin_amdgcn_s_setprio(1); _Pragma("unroll") for (int m = 0; m < 4; ++m) _Pragma("unroll") for (int n = 0; n < 2; ++n) _Pragma("unroll") for (int k = 0; k < 2; ++k) \
        acc[ai][bj][m][n] = __builtin_amdgcn_mfma_i32_16x16x64_i8(__builtin_bit_cast(i32x4, Bt[n][k]), __builtin_bit_cast(i32x4, At[m][k]), acc[ai][bj][m][n], 0, 0, 0); __builtin_amdgcn_s_setprio(0); } while (0)
#define PG8_WAIT_V(n) asm volatile("s_waitcnt vmcnt(" #n ")" ::: "memory")
#define PG8_WAIT_L(n) asm volatile("s_waitcnt lgkmcnt(" #n ")" ::: "memory")
#define PG8_BAR __builtin_amdgcn_s_barrier()
#define PG8_SCHED __builtin_amdgcn_sched_barrier(0)
    Unit cur, nxt; int ui = 0;
    if (!S.next(0, cur)) return;
    i32x4 acc[2][2][4][2];
#pragma unroll
    for (int a = 0; a < 2; ++a)
#pragma unroll
        for (int b = 0; b < 2; ++b)
#pragma unroll
            for (int m = 0; m < 4; ++m)
#pragma unroll
                for (int n = 0; n < 2; ++n) acc[a][b][m][n] = (i32x4){0, 0, 0, 0};
    bf16x8 At[4][2], B0[2][2], B1[2][2];
    typename Epi::Pre pre;
    const char* cA = (const char*)g.A + (size_t)cur.pm * tstepA; const char* cB = (const char*)g.Bt + (size_t)cur.pn * tstepB;
    S.a_ready(cur);
    if constexpr (SP2) {
        PG8_STAGE(PG8_SB(0, 0), cB, voffB); PG8_STAGE(PG8_SB(0, 1), cB + hstepB, voffB); PG8_STAGE(PG8_SA(0, 0), cA, voffA); PG8_STAGE(PG8_SA(0, 1), cA + hstepA, voffA);
        if (wr == 1) PG8_BAR;
        PG8_WAIT_V(2); PG8_BAR;
        PG8_STAGE(PG8_SB(1, 0), cB + kstep, voffB); PG8_STAGE(PG8_SA(1, 0), cA + kstep, voffA); PG8_STAGE(PG8_SB(1, 1), cB + hstepB + kstep, voffB);
        PG8_WAIT_V(6); PG8_BAR;
    } else {
        PG8_STAGE(PG8_SB(0, 0), cB, voffB); PG8_STAGE(PG8_SA(0, 0), cA, voffA); PG8_STAGE(PG8_SB(0, 1), cB + hstepB, voffB); PG8_STAGE(PG8_SA(0, 1), cA + hstepA, voffA);
        if (wr == 1) PG8_BAR;
        PG8_WAIT_V(4); PG8_BAR;
        PG8_STAGE(PG8_SB(1, 0), cB + kstep, voffB); PG8_STAGE(PG8_SA(1, 0), cA + kstep, voffA); PG8_STAGE(PG8_SB(1, 1), cB + hstepB + kstep, voffB);
        PG8_WAIT_V(6); PG8_BAR;
    }
    for (;;) {
        const bool has_next = S.next(ui + 1, nxt);
        const char* nA = has_next ? (const char*)g.A + (size_t)nxt.pm * tstepA : cA; const char* nB = has_next ? (const char*)g.Bt + (size_t)nxt.pn * tstepB : cB;
        for (int t = 0; t < nt; t += 2) {
            const bool last = (t == nt - 2);
            const char* a1 = cA + (size_t)(t + 1) * kstep;
            const char* a2 = last ? nA : cA + (size_t)(t + 2) * kstep; const char* b2 = last ? nB : cB + (size_t)(t + 2) * kstep;
            const char* a3 = a2 + kstep; const char* b3 = b2 + kstep;
            if (last && has_next) S.a_ready(nxt);
            if constexpr (Epi::HAS_PRE) { if (last) E.preload(pre, cur, wid, lane); }
            if constexpr (SP2) {
            PG8_LDB(B0, 0, 0); PG8_LDB(B1, 0, 1); PG8_SCHED; PG8_LDA(At, 0, 0); PG8_STAGE(PG8_SA(1, 1), a1 + hstepA, voffA);
            PG8_WAIT_V(8); PG8_WAIT_L(0); PG8_BAR; PG8_MMA(0, 0, At, B0); PG8_MMA(0, 1, At, B1); PG8_BAR; PG8_SCHED;
            PG8_LDA(At, 0, 1); PG8_STAGE(PG8_SB(0, 0), b2, voffB); PG8_STAGE(PG8_SB(0, 1), b2 + hstepB, voffB); PG8_STAGE(PG8_SA(0, 0), a2, voffA);
            PG8_WAIT_V(8); PG8_WAIT_L(0); PG8_BAR; PG8_MMA(1, 0, At, B0); PG8_MMA(1, 1, At, B1); PG8_BAR; PG8_SCHED;
            PG8_LDB(B0, 1, 0); PG8_LDB(B1, 1, 1); PG8_SCHED; PG8_LDA(At, 1, 0); PG8_STAGE(PG8_SA(0, 1), a2 + hstepA, voffA);
            PG8_WAIT_V(8); PG8_WAIT_L(0); PG8_BAR; PG8_MMA(0, 0, At, B0); PG8_MMA(0, 1, At, B1); PG8_BAR; PG8_SCHED;
            PG8_LDA(At, 1, 1); PG8_STAGE(PG8_SB(1, 0), b3, voffB); PG8_STAGE(PG8_SB(1, 1), b3 + hstepB, voffB); PG8_STAGE(PG8_SA(1, 0), a3, voffA);
            PG8_WAIT_V(8); PG8_WAIT_L(0); PG8_BAR; PG8_MMA(1, 0, At, B0); PG8_MMA(1, 1, At, B1); PG8_BAR; PG8_SCHED;
            } else {
            PG8_LDB(B0, 0, 0); PG8_SCHED; PG8_LDA(At, 0, 0); PG8_STAGE(PG8_SA(1, 1), a1 + hstepA, voffA);
            PG8_WAIT_L(8); PG8_BAR; PG8_WAIT_L(0); PG8_MMA(0, 0, At, B0); PG8_BAR; PG8_SCHED;
            PG8_LDB(B1, 0, 1); PG8_STAGE(PG8_SB(0, 0), b2, voffB);
            PG8_BAR; PG8_WAIT_L(0); PG8_MMA(0, 1, At, B1); PG8_BAR;
            PG8_LDA(At, 0, 1); PG8_STAGE(PG8_SA(0, 0), a2, voffA);
            PG8_BAR; PG8_WAIT_L(0); PG8_MMA(1, 0, At, B0); PG8_BAR; PG8_SCHED;
            PG8_STAGE(PG8_SB(0, 1), b2 + hstepB, voffB);
            PG8_WAIT_V(6); PG8_BAR; PG8_MMA(1, 1, At, B1); PG8_BAR;
            PG8_LDB(B0, 1, 0); PG8_SCHED; PG8_LDA(At, 1, 0); PG8_STAGE(PG8_SA(0, 1), a2 + hstepA, voffA);
            PG8_WAIT_L(8); PG8_BAR; PG8_WAIT_L(0); PG8_MMA(0, 0, At, B0); PG8_BAR; PG8_SCHED;
            PG8_LDB(B1, 1, 1); PG8_STAGE(PG8_SB(1, 0), b3, voffB);
            PG8_BAR; PG8_WAIT_L(0); PG8_MMA(0, 1, At, B1); PG8_BAR;
            PG8_LDA(At, 1, 1); PG8_STAGE(PG8_SA(1, 0), a3, voffA);
            PG8_BAR; PG8_WAIT_L(0); PG8_MMA(1, 0, At, B0); PG8_BAR; PG8_SCHED;
            PG8_STAGE(PG8_SB(1, 1), b3 + hstepB, voffB);
            PG8_WAIT_V(6); PG8_BAR; PG8_MMA(1, 1, At, B1); PG8_BAR;
            }
        }
        if constexpr (ALIGN_EPI) { if (wr == 0) PG8_BAR; }
        if constexpr (!Epi::AFTER_DRAIN) { if constexpr (Epi::HAS_PRE) E(acc, cur, wr, wc, fr, fq, pre); else E(acc, cur, wr, wc, fr, fq); S.done(cur); }
        if (!has_next) break;
#pragma unroll
        for (int a = 0; a < 2; ++a)
#pragma unroll
            for (int b = 0; b < 2; ++b)
#pragma unroll
                for (int m = 0; m < 4; ++m)
#pragma unroll
                    for (int n = 0; n < 2; ++n) acc[a][b][m][n] = (i32x4){0, 0, 0, 0};
        cur = nxt; cA = nA; cB = nB; ++ui;
        if constexpr (ALIGN_EPI) { if (wr == 1) PG8_BAR; }
    }
    PG8_WAIT_V(0);
    if constexpr (!ALIGN_EPI) { if (wr == 0) PG8_BAR; }
    PG8_BAR;
    if constexpr (Epi::AFTER_DRAIN) { E.fused(acc, cur, wr, wc, fr, fq, lds, wid, lane); S.done(cur); }
#undef PG8_SA
#undef PG8_SB
#undef PG8_STAGE
#undef PG8_LDA
#undef PG8_LDB
#undef PG8_MMA
#undef PG8_WAIT_V
#undef PG8_WAIT_L
#undef PG8_BAR
#undef PG8_SCHED
}
template <class Epi, class Sched, bool ALIGN_EPI = false, bool SP2 = false>
__device__ __forceinline__ void gemm_phase_dual(PG8_LAS unsigned char* lds, const Gemm g, const Sched& S, const Epi& E) {
    const int tid = threadIdx.x, wid = __builtin_amdgcn_readfirstlane(tid >> 6), lane = tid & 63, wr = wid >> 2, wc = wid & 3, fr = lane & 15, fq = lane >> 4;
    const int K = g.K, nt = K / BK;
    unsigned voffA[2], voffA2[2], voffB[2];
#pragma unroll
    for (int i = 0; i < 2; ++i) { int R, C; stage_rc(tid * 16 + i * 8192, R, C); const int Rb = Epi::PERM ? ((R & ~31) + perm32(R & 31)) : R;
        voffA[i] = (unsigned)(R * g.lda + C) * 2u; voffA2[i] = (unsigned)(R * g.lda2 + C) * 2u; voffB[i] = (unsigned)(Rb * K + C) * 2u; }
    const size_t kstep = (size_t)(BK * 2);
    const size_t hstepB = (size_t)HALF * K * 2, hstepA = (size_t)HALF * g.lda * 2, hstepA2 = (size_t)HALF * g.lda2 * 2; const int nt1 = g.K1 / BK;
    const size_t tstepA = 2 * hstepA, tstepA2 = 2 * hstepA2, tstepB = 2 * hstepB;
    const unsigned ldsw = (unsigned)wid * 1024u;
    const int aoff = lds_byte(wr * 64 + fr, fq * 8), boff = lds_byte(wc * 32 + fr, fq * 8);
#define PG8_SA(b, h) (((b) * 2 + (h)) * HTB)
#define PG8_SB(b, h) ((4 + (b) * 2 + (h)) * HTB)
#define PG8_STAGE(bufoff, gbase, voff) do { _Pragma("unroll") for (int _i = 0; _i < 2; ++_i) \
        __builtin_amdgcn_global_load_lds((const unsigned*)((const char*)(gbase) + (voff)[_i]), (PG8_LAS unsigned*)(lds + (bufoff) + ldsw + _i * 8192), 16, 0, 0); } while (0)
#define PG8_LDA(dst, b, h) do { _Pragma("unroll") for (int m = 0; m < 4; ++m) _Pragma("unroll") for (int k = 0; k < 2; ++k) dst[m][k] = *(const PG8_LAS bf16x8*)(lds + PG8_SA(b, h) + aoff + m * 2048 + k * 1024); } while (0)
#define PG8_LDB(dst, b, h) do { _Pragma("unroll") for (int n = 0; n < 2; ++n) _Pragma("unroll") for (int k = 0; k < 2; ++k) dst[n][k] = *(const PG8_LAS bf16x8*)(lds + PG8_SB(b, h) + boff + n * 2048 + k * 1024); } while (0)
#define PG8_MMA(ai, bj, At, Bt) do { __builtin_amdgcn_s_setprio(1); _Pragma("unroll") for (int m = 0; m < 4; ++m) _Pragma("unroll") for (int n = 0; n < 2; ++n) _Pragma("unroll") for (int k = 0; k < 2; ++k) \
        acc[ai][bj][m][n] = __builtin_amdgcn_mfma_f32_16x16x32_bf16(Bt[n][k], At[m][k], acc[ai][bj][m][n], 0, 0, 0); __builtin_amdgcn_s_setprio(0); } while (0)
#define PG8_WAIT_V(n) asm volatile("s_waitcnt vmcnt(" #n ")" ::: "memory")
#define PG8_WAIT_L(n) asm volatile("s_waitcnt lgkmcnt(" #n ")" ::: "memory")
#define PG8_BAR __builtin_amdgcn_s_barrier()
#define PG8_SCHED __builtin_amdgcn_sched_barrier(0)
    Unit cur, nxt; int ui = 0;
    if (!S.next(0, cur)) return;
    f32x4 acc[2][2][4][2];
#pragma unroll
    for (int a = 0; a < 2; ++a)
#pragma unroll
        for (int b = 0; b < 2; ++b)
#pragma unroll
            for (int m = 0; m < 4; ++m)
#pragma unroll
                for (int n = 0; n < 2; ++n) acc[a][b][m][n] = (f32x4){0.f, 0.f, 0.f, 0.f};
    bf16x8 At[4][2], B0[2][2], B1[2][2];
    const char* cA = (const char*)g.A + (size_t)cur.pm * tstepA; const char* cA2 = (const char*)g.A2 + (size_t)cur.pm * tstepA2; const char* cB = (const char*)g.Bt + (size_t)cur.pn * tstepB;
    S.a_ready(cur);
    if constexpr (SP2) {
        PG8_STAGE(PG8_SB(0, 0), cB, voffB); PG8_STAGE(PG8_SB(0, 1), cB + hstepB, voffB); PG8_STAGE(PG8_SA(0, 0), cA, voffA); PG8_STAGE(PG8_SA(0, 1), cA + hstepA, voffA);
        if (wr == 1) PG8_BAR;
        PG8_WAIT_V(2); PG8_BAR;
        PG8_STAGE(PG8_SB(1, 0), cB + kstep, voffB); PG8_STAGE(PG8_SA(1, 0), cA + kstep, voffA); PG8_STAGE(PG8_SB(1, 1), cB + hstepB + kstep, voffB);
        PG8_WAIT_V(6); PG8_BAR;
    } else {
        PG8_STAGE(PG8_SB(0, 0), cB, voffB); PG8_STAGE(PG8_SA(0, 0), cA, voffA); PG8_STAGE(PG8_SB(0, 1), cB + hstepB, voffB); PG8_STAGE(PG8_SA(0, 1), cA + hstepA, voffA);
        if (wr == 1) PG8_BAR;
        PG8_WAIT_V(4); PG8_BAR;
        PG8_STAGE(PG8_SB(1, 0), cB + kstep, voffB); PG8_STAGE(PG8_SA(1, 0), cA + kstep, voffA); PG8_STAGE(PG8_SB(1, 1), cB + hstepB + kstep, voffB);
        PG8_WAIT_V(6); PG8_BAR;
    }
    for (;;) {
        const bool has_next = S.next(ui + 1, nxt);
        const char* nA = has_next ? (const char*)g.A + (size_t)nxt.pm * tstepA : cA; const char* nA2 = has_next ? (const char*)g.A2 + (size_t)nxt.pm * tstepA2 : cA2; const char* nB = has_next ? (const char*)g.Bt + (size_t)nxt.pn * tstepB : cB;
        for (int t = 0; t < nt; t += 2) {
            const bool last = (t == nt - 2);
#define PG8_TILEP(T) ((T) < nt1 ? cA + (size_t)(T) * kstep : cA2 + (size_t)((T) - nt1) * kstep)
            if (t == nt1) E.mid(acc, cur, wr, wc, fr, fq);
            const char* a1 = PG8_TILEP(t + 1); const bool s1 = (t + 1) >= nt1;
            const char* a2 = last ? nA : PG8_TILEP(t + 2); const bool s2 = last ? false : (t + 2) >= nt1;
            const char* a3 = last ? nA + kstep : PG8_TILEP(t + 3); const bool s3 = last ? false : (t + 3) >= nt1;
            const char* b2 = last ? nB : cB + (size_t)(t + 2) * kstep; const char* b3 = b2 + kstep;
#define PG8_STAGE_A(bufoff, ptr, sec, half) do { const char* _p = (ptr) + ((half) ? ((sec) ? hstepA2 : hstepA) : (size_t)0); _Pragma("unroll") for (int _i = 0; _i < 2; ++_i) \
        __builtin_amdgcn_global_load_lds((const unsigned*)(_p + ((sec) ? voffA2[_i] : voffA[_i])), (PG8_LAS unsigned*)(lds + (bufoff) + ldsw + _i * 8192), 16, 0, 0); } while (0)
            if (last && has_next) S.a_ready(nxt);
            if constexpr (SP2) {
            PG8_LDB(B0, 0, 0); PG8_LDB(B1, 0, 1); PG8_SCHED; PG8_LDA(At, 0, 0); PG8_STAGE_A(PG8_SA(1, 1), a1, s1, 1);
            PG8_WAIT_V(8); PG8_WAIT_L(0); PG8_BAR; PG8_MMA(0, 0, At, B0); PG8_MMA(0, 1, At, B1); PG8_BAR; PG8_SCHED;
            PG8_LDA(At, 0, 1); PG8_STAGE(PG8_SB(0, 0), b2, voffB); PG8_STAGE(PG8_SB(0, 1), b2 + hstepB, voffB); PG8_STAGE_A(PG8_SA(0, 0), a2, s2, 0);
            PG8_WAIT_V(8); PG8_WAIT_L(0); PG8_BAR; PG8_MMA(1, 0, At, B0); PG8_MMA(1, 1, At, B1); PG8_BAR; PG8_SCHED;
            PG8_LDB(B0, 1, 0); PG8_LDB(B1, 1, 1); PG8_SCHED; PG8_LDA(At, 1, 0); PG8_STAGE_A(PG8_SA(0, 1), a2, s2, 1);
            PG8_WAIT_V(8); PG8_WAIT_L(0); PG8_BAR; PG8_MMA(0, 0, At, B0); PG8_MMA(0, 1, At, B1); PG8_BAR; PG8_SCHED;
            PG8_LDA(At, 1, 1); PG8_STAGE(PG8_SB(1, 0), b3, voffB); PG8_STAGE(PG8_SB(1, 1), b3 + hstepB, voffB); PG8_STAGE_A(PG8_SA(1, 0), a3, s3, 0);
            PG8_WAIT_V(8); PG8_WAIT_L(0); PG8_BAR; PG8_MMA(1, 0, At, B0); PG8_MMA(1, 1, At, B1); PG8_BAR; PG8_SCHED;
            }
        }
        if constexpr (ALIGN_EPI) { if (wr == 0) PG8_BAR; }
        if constexpr (!Epi::AFTER_DRAIN) { E(acc, cur, wr, wc, fr, fq); S.done(cur); }
        if (!has_next) break;
#pragma unroll
        for (int a = 0; a < 2; ++a)
#pragma unroll
            for (int b = 0; b < 2; ++b)
#pragma unroll
                for (int m = 0; m < 4; ++m)
#pragma unroll
                    for (int n = 0; n < 2; ++n) acc[a][b][m][n] = (f32x4){0.f, 0.f, 0.f, 0.f};
        cur = nxt; cA = nA; cA2 = nA2; cB = nB; ++ui;
        if constexpr (ALIGN_EPI) { if (wr == 1) PG8_BAR; }
    }
    PG8_WAIT_V(0);
    if constexpr (!ALIGN_EPI) { if (wr == 0) PG8_BAR; }
    PG8_BAR;
    if constexpr (Epi::AFTER_DRAIN) { E.fused(acc, cur, wr, wc, fr, fq, lds, wid, lane); S.done(cur); }
#undef PG8_TILEP
#undef PG8_STAGE_A
#undef PG8_SA
#undef PG8_SB
#undef PG8_STAGE
#undef PG8_LDA
#undef PG8_LDB
#undef PG8_MMA
#undef PG8_WAIT_V
#undef PG8_WAIT_L
#undef PG8_BAR
#undef PG8_SCHED
}
}
#define GAS __attribute__((address_space(1)))
#define LAS __attribute__((address_space(3)))
typedef unsigned short bf16;
typedef unsigned v4u __attribute__((ext_vector_type(4)));
typedef float f32x4 __attribute__((ext_vector_type(4)));
typedef short bf16x8 __attribute__((ext_vector_type(8)));
typedef GAS unsigned gu32;
typedef GAS unsigned long long gu64;
#define RLX_AGENT __ATOMIC_RELAXED, __HIP_MEMORY_SCOPE_AGENT
#define LDS_WAIT() asm volatile("s_waitcnt lgkmcnt(0)" ::: "memory")
#define VM_WAIT() asm volatile("s_waitcnt vmcnt(0)" ::: "memory")
__device__ __forceinline__ unsigned long long rt() { return __builtin_amdgcn_s_memrealtime(); }
__device__ __forceinline__ unsigned f2bf(float f) { unsigned u = __builtin_bit_cast(unsigned, f); return (u + 0x7fffu + ((u >> 16) & 1u)) >> 16; }
__device__ __forceinline__ unsigned pk2(float lo, float hi) { return f2bf(lo) | (f2bf(hi) << 16); }

#define XB_TMO      128
#define XB_XCNT(j)  (256  + 64 * (j))
#define XB_XSUB(j)  (1280 + 64 * (j))
#define XB_XGEN(j)  (2304 + 64 * (j))
#define XB_TOP      3328
#define XB_TOPGEN   3392
#define XCD_BAR_WORDS 3456
#define XB_SPIN_CAP (1u << 18)

__device__ __forceinline__ unsigned xb_ld(unsigned* p)              { return __hip_atomic_load(p, __ATOMIC_RELAXED, __HIP_MEMORY_SCOPE_AGENT); }
__device__ __forceinline__ unsigned xb_add(unsigned* p, unsigned v) { return __hip_atomic_fetch_add(p, v, __ATOMIC_RELAXED, __HIP_MEMORY_SCOPE_AGENT); }
__device__ __forceinline__ unsigned xb_xcc_id() { return (unsigned)__builtin_amdgcn_s_getreg((3 << 11) | 20) & 0xFu; }
#define XB_SPIN(cond, bar) do { unsigned _sp = 0; while (cond) { __builtin_amdgcn_s_sleep(1); \
    if ((++_sp & 255u) == 0u) { if (xb_ld(&(bar)[XB_TMO])) break; if (_sp > XB_SPIN_CAP) { atomicAdd(&(bar)[XB_TMO], 1u); break; } } } } while (0)

struct XcdBarrier {
    unsigned* bar; unsigned x;
    volatile LAS unsigned* st;
};

__device__ __forceinline__ XcdBarrier xcd_barrier_post(unsigned* bar, volatile LAS unsigned* st) {
    XcdBarrier b; b.bar = bar; b.x = xb_xcc_id(); b.st = st;
    if (threadIdx.x == 0) (void)xb_add(&bar[XB_XCNT(b.x)], 1u);
    return b;
}
__device__ __forceinline__ void xcd_barrier_complete(unsigned* bar, unsigned x, unsigned& nloc, unsigned& nx) {
    const unsigned G = gridDim.x * gridDim.y * gridDim.z;
    unsigned sum, cnt, mine, sp = 0u;
    for (;;) {
        sum = 0u; cnt = 0u; mine = 0u;
#pragma unroll
        for (unsigned j = 0; j < 16; ++j) { const unsigned c = xb_ld(&bar[XB_XCNT(j)]); sum += c; cnt += (c > 0u) ? 1u : 0u; mine = (j == x) ? c : mine; }
        if (sum == G) break;
        __builtin_amdgcn_s_sleep(1);
        if ((++sp & 255u) == 0u) { if (xb_ld(&bar[XB_TMO])) break; if (sp > XB_SPIN_CAP) { atomicAdd(&bar[XB_TMO], 1u); break; } }
    }
    nloc = mine > 0u ? mine : 1u; nx = cnt > 0u ? cnt : 1u;
}

__device__ __forceinline__ void xcd_barrier(const XcdBarrier& b) {
    asm volatile("s_waitcnt vmcnt(0)" ::: "memory");
    __syncthreads();
    if (threadIdx.x == 0) {
        unsigned* bar = b.bar;
        __builtin_amdgcn_s_waitcnt(0);
        unsigned nloc = b.st[0], nx = b.st[1];
        if (nloc == 0u) { xcd_barrier_complete(bar, b.x, nloc, nx); b.st[0] = nloc; b.st[1] = nx; }
        const unsigned old = xb_add(&bar[XB_XSUB(b.x)], 1u);
        const unsigned gen = old / nloc;
        if (old + 1u == (gen + 1u) * nloc) {
            __builtin_amdgcn_fence(__ATOMIC_RELEASE, "agent");
            asm volatile("s_waitcnt vmcnt(0)" ::: "memory");
            const unsigned og = xb_add(&bar[XB_TOP], 1u);
            const unsigned tg = og / nx;
            if (og + 1u == (tg + 1u) * nx) xb_add(&bar[XB_TOPGEN], 1u);
            else XB_SPIN(xb_ld(&bar[XB_TOPGEN]) == tg, bar);
            __builtin_amdgcn_fence(__ATOMIC_ACQUIRE, "agent");
            xb_add(&bar[XB_XGEN(b.x)], 1u);
            asm volatile("s_waitcnt vmcnt(0)" ::: "memory");
        } else {
            XB_SPIN(xb_ld(&bar[XB_XGEN(b.x)]) == gen, bar);
            __builtin_amdgcn_fence(__ATOMIC_ACQUIRE, "agent");
            asm volatile("s_waitcnt vmcnt(0)" ::: "memory");
        }
    }
    __syncthreads();
}

constexpr int D = 1024, BATCH = 16, SEQ = 4096, M = BATCH * SEQ;
constexpr int INW = 6416, NP = 6400;
constexpr int LDP = pg8::LDP;
constexpr int C_AQ = 0, C_AK = 1024, C_AV = 1152, C_MQ = 1280, C_MK = 1792, C_MV = 2304, C_MO = 3328, C_GA = 4352, C_GM = 5376;
constexpr int C_ATT = 0;
constexpr int C_HMN = C_MV;
constexpr int C_MIX = 0;
constexpr int C_X1B = 1024;
constexpr int C_QB = 2048;
constexpr float EPS = 1e-6f, GATE_CAP = 15.0f;
constexpr int NEXP = 16384;

constexpr size_t MiB = 1u << 20;
constexpr size_t WS_CTL = 0, CTL_ZERO_BYTES = 1 * MiB;
constexpr size_t WS_W1T = 1 * MiB;
constexpr size_t WS_WAT = 14 * MiB, WS_WMT = 16 * MiB, WS_WOT = 18 * MiB, WS_WQT = 20 * MiB;
constexpr size_t WS_KEYS = 22 * MiB;
constexpr size_t WS_GATES = 23 * MiB;
constexpr size_t WS_ROPE = 27 * MiB;
constexpr size_t WS_SSQ = 31 * MiB;
constexpr size_t WS_DOWN = 36 * MiB, WS_UP = 52 * MiB;
constexpr size_t WS_SCD = 68 * MiB, WS_SCU = 69 * MiB;
constexpr size_t WS_IDX = 100 * MiB, WS_GATE = 132 * MiB;
constexpr size_t WS_COEF = 964 * MiB;
constexpr size_t WS_PROJ = 164 * MiB;
constexpr size_t WS_END = 996 * MiB;
constexpr int CW_BAR = 4096;
constexpr int CW_QUEUE = 64;
constexpr int CW_XRANK = 1024;
constexpr int CW_SWMAX = 131072;

constexpr int RING_OFF = 0, RING_BYTES = 131072;
constexpr int LDSCTL_OFF = RING_BYTES, MISC_OFF = LDSCTL_OFF + 320;
constexpr int LDS_BYTES = 147456;
constexpr int NWAVES = 8, NTHREADS = 512;

#define DPP_ROW_SHR(n) (0x110 + (n))
#define DPP_BCAST15 0x142
#define DPP_BCAST31 0x143
template <int CTRL, int ROW_MASK> __device__ __forceinline__ float dpp_f(float identity, float v) {
    return __builtin_bit_cast(float, __builtin_amdgcn_update_dpp(__builtin_bit_cast(int, identity), __builtin_bit_cast(int, v), CTRL, ROW_MASK, 0xf, false));
}
#define DPP_SCAN(v, identity, OP) do { \
    v = OP(v, (dpp_f<DPP_ROW_SHR(1), 0xf>(identity, v))); v = OP(v, (dpp_f<DPP_ROW_SHR(2), 0xf>(identity, v))); v = OP(v, (dpp_f<DPP_ROW_SHR(4), 0xf>(identity, v))); v = OP(v, (dpp_f<DPP_ROW_SHR(8), 0xf>(identity, v))); \
    v = OP(v, (dpp_f<DPP_BCAST15, 0xa>(identity, v))); v = OP(v, (dpp_f<DPP_BCAST31, 0xc>(identity, v))); } while (0)
#define DPP_ADD(a, b) ((a) + (b))
#define DPP_MAX(a, b) fmaxf((a), (b))
__device__ __forceinline__ float lane_bcast(float v, int l) { return __builtin_bit_cast(float, __builtin_amdgcn_readlane(__builtin_bit_cast(int, v), l)); }
__device__ __forceinline__ float sum8_dpp(float v, int lane) {
    v += __builtin_bit_cast(float, __builtin_amdgcn_update_dpp(0, __builtin_bit_cast(int, v), 0xB1, 0xf, 0xf, true));
    v += __builtin_bit_cast(float, __builtin_amdgcn_update_dpp(0, __builtin_bit_cast(int, v), 0x4E, 0xf, 0xf, true));
    const float up = __builtin_bit_cast(float, __builtin_amdgcn_update_dpp(0, __builtin_bit_cast(int, v), 0x104, 0xf, 0xf, true));
    const float dn = __builtin_bit_cast(float, __builtin_amdgcn_update_dpp(0, __builtin_bit_cast(int, v), 0x114, 0xf, 0xf, true));
    return v + ((lane & 4) ? dn : up);
}
__device__ __forceinline__ float wave_sum(float v) { DPP_SCAN(v, 0.f, DPP_ADD); return lane_bcast(v, 63); }
__device__ __forceinline__ float wave_max(float v) { DPP_SCAN(v, -INFINITY, DPP_MAX); return lane_bcast(v, 63); }
__device__ __forceinline__ float bf2f(bf16 b) { return __builtin_bit_cast(float, (unsigned)b << 16); }

struct Args { const void* in[18]; float* out; unsigned char* ws; int ph_lo, ph_hi; };

struct Frame {
    LAS unsigned char* lds;
    volatile LAS unsigned* MISC;
    gu32* ctl;
    int tid, lane, wave, G;
};

__device__ __forceinline__ void p0_transpose_item(const float* W, int ldw, int srccol0, int k0, bf16* WT, int K, int dstrow0, const float* kscale, LAS float* scr, int lane, int kdst = 0) {
#pragma unroll 8
    for (int i = 0; i < 32; ++i) { const int kk = 2 * i + (lane >> 5); float v = W[(size_t)(k0 + kk) * ldw + srccol0 + (lane & 31)]; if (kscale) v *= kscale[k0 + kk]; scr[kk * 33 + (lane & 31)] = v; }
    LDS_WAIT(); asm volatile("" ::: "memory");
    const int c = lane & 7;
#pragma unroll
    for (int j = 0; j < 4; ++j) { const int n = (lane >> 3) + 8 * j; const LAS float* s = scr + (8 * c) * 33 + n;
        v4u o; o.x = pk2(s[0 * 33], s[1 * 33]); o.y = pk2(s[2 * 33], s[3 * 33]); o.z = pk2(s[4 * 33], s[5 * 33]); o.w = pk2(s[6 * 33], s[7 * 33]);
        *(GAS v4u*)(WT + (size_t)(dstrow0 + n) * K + kdst + k0 + 8 * c) = o; }
    LDS_WAIT(); asm volatile("" ::: "memory");
}

constexpr int TQ_UNITS = 2 * NEXP / 128;
__device__ __forceinline__ void quant_tables_unit(Frame& F, const Args& a, int unit) {
    const float* g2 = (const float*)a.in[13]; const float* pdown = (const float*)a.in[16]; const float* pup = (const float*)a.in[17];
    unsigned char* ws = a.ws;
    const int row0 = unit * 128 + F.wave * 16;
    f32x4 nrow[4];
    { const float* src = (row0 >= NEXP ? pup + (size_t)(row0 - NEXP) * D : pdown + (size_t)row0 * D) + 16 * F.lane;
#pragma unroll
      for (int q = 0; q < 4; ++q) nrow[q] = *(const f32x4*)(src + 4 * q); }
    f32x4 g2v[4];
#pragma unroll
    for (int q = 0; q < 4; ++q) g2v[q] = *(const f32x4*)(g2 + 16 * F.lane + 4 * q);
#pragma unroll 1
    for (int i = 0; i < 16; ++i) {
        const int row = row0 + i;
        const bool up = row >= NEXP; const int e = up ? row - NEXP : row;
        f32x4 cur[4];
#pragma unroll
        for (int q = 0; q < 4; ++q) cur[q] = nrow[q];
        { const int rn = (i + 1 < 16) ? row + 1 : row; const float* src = (rn >= NEXP ? pup + (size_t)(rn - NEXP) * D : pdown + (size_t)rn * D) + 16 * F.lane;
#pragma unroll
          for (int q = 0; q < 4; ++q) nrow[q] = *(const f32x4*)(src + 4 * q); }
        float v[16]; float am = 0.f;
#pragma unroll
        for (int q = 0; q < 4; ++q) { const f32x4 a4 = cur[q]; f32x4 s4 = {1.f, 1.f, 1.f, 1.f}; if (!up) s4 = g2v[q];
#pragma unroll
            for (int k = 0; k < 4; ++k) { v[4 * q + k] = a4[k] * s4[k]; am = fmaxf(am, fabsf(v[4 * q + k])); } }
        am = fmaxf(wave_max(am), 1e-30f);
        const float sc = up ? am * (1.0f / 448.0f) : am * (1.0f / 127.0f), isc = up ? 448.0f / am : 127.0f / am;
        unsigned w[4];
#pragma unroll
        for (int q = 0; q < 4; ++q) {
            if (up) { int pk = 0; pk = __builtin_amdgcn_cvt_pk_fp8_f32(v[4 * q] * isc, v[4 * q + 1] * isc, pk, false); pk = __builtin_amdgcn_cvt_pk_fp8_f32(v[4 * q + 2] * isc, v[4 * q + 3] * isc, pk, true); w[q] = (unsigned)pk; }
            else { unsigned acc4 = 0u;
#pragma unroll
                for (int k = 0; k < 4; ++k) { int qi = (int)__builtin_rintf(v[4 * q + k] * isc); qi = qi < -127 ? -127 : (qi > 127 ? 127 : qi); acc4 |= (unsigned)(qi & 0xff) << (8 * k); }
                w[q] = acc4; } }
        unsigned char* dstp = up ? (unsigned char*)(ws + WS_UP) + (size_t)(F.lane >> 3) * ((size_t)NEXP * 128) + (size_t)e * 128 + 16 * (F.lane & 7) : (unsigned char*)(ws + WS_DOWN) + (size_t)e * D + 16 * F.lane;
        *(v4u*)dstp = (v4u){w[0], w[1], w[2], w[3]};
        if (F.lane == 0) ((float*)(ws + (up ? WS_SCU : WS_SCD)))[e] = sc;
    }
}
__device__ __forceinline__ void p0_prologue(Frame& F, const Args& a, int pass) {
    const float* x = (const float*)a.in[0]; const int* pos = (const int*)a.in[1]; const float* g1 = (const float*)a.in[2]; const float* w_in = (const float*)a.in[3];
    const float* ibias = (const float*)a.in[4]; const float* fbias = (const float*)a.in[5];
    const float* wa = (const float*)a.in[10]; const float* wm = (const float*)a.in[11]; const float* wo = (const float*)a.in[12];
    const float* g2 = (const float*)a.in[13]; const float* wq = (const float*)a.in[14]; const float* skeys = (const float*)a.in[15];
    const float* pdown = (const float*)a.in[16]; const float* pup = (const float*)a.in[17];
    unsigned char* ws = a.ws;
    bf16* WAT = (bf16*)(ws + WS_WAT); bf16* WMT = (bf16*)(ws + WS_WMT); bf16* WOT = (bf16*)(ws + WS_WOT); bf16* WQT = (bf16*)(ws + WS_WQT);
    bf16* KEYS = (bf16*)(ws + WS_KEYS); float* GATES = (float*)(ws + WS_GATES); float* ROPE = (float*)(ws + WS_ROPE);
    unsigned char* XN8 = (unsigned char*)a.out; float* SX = (float*)(ws + WS_SSQ);
    const int gw = blockIdx.x * NWAVES + F.wave, NGW = F.G * NWAVES;
    const int gt = blockIdx.x * NTHREADS + F.tid, NGT = F.G * NTHREADS;
    LAS float* scr = (LAS float*)(F.lds + RING_OFF + F.wave * 8704);
    constexpr int I_1 = 16 * 200, I_S = 16 * 32;
    gu32* SWMAX = F.ctl + CW_SWMAX;
    auto w1_src = [](int n0) { int src = n0 + (n0 >= 3328 ? 16 : 0); if (n0 >= C_GA) { const int o = n0 - C_GA, j = o >> 8, hf = (o >> 7) & 1, wi = o & 127; src = (hf ? 5392 : 4368) + 128 * j + wi; } return src; };
    if (pass == 0) {
        for (int it = gw; it < I_1; it += NGW) {
            const int kb = it / 200, nb = it % 200, n0 = nb * 32, src = w1_src(n0);
            float mx = 0.f;
#pragma unroll 8
            for (int i = 0; i < 32; ++i) { const int kk = 2 * i + (F.lane >> 5); mx = fmaxf(mx, fabsf(w_in[(size_t)(kb * 64 + kk) * INW + src + (F.lane & 31)])); }
            mx = fmaxf(mx, __shfl_xor(mx, 32));
            if (F.lane < 32) __hip_atomic_fetch_max(SWMAX + n0 + F.lane, __builtin_bit_cast(unsigned, mx), RLX_AGENT);
        }
        for (int it = gw; it < 4 * I_S; it += NGW) {
            const int which = it / I_S, r = it % I_S, kb = r / 32, nb = r % 32;
            const float* W = which == 0 ? wa : which == 1 ? wm : which == 2 ? wo : wq;
            if (which < 2) p0_transpose_item(W, D, nb * 32, kb * 64, WAT, 2 * D, nb * 32, nullptr, scr, F.lane, which * D);
            else {
                const bool isq = which == 3; float mx = 0.f;
#pragma unroll 8
                for (int i = 0; i < 32; ++i) { const int kk = kb * 64 + 2 * i + (F.lane >> 5); mx = fmaxf(mx, fabsf(W[(size_t)kk * D + nb * 32 + (F.lane & 31)] * (isq ? g2[kk] : 1.f))); }
                mx = fmaxf(mx, __shfl_xor(mx, 32));
                if (F.lane < 32) __hip_atomic_fetch_max(SWMAX + NP + (isq ? 0 : D) + nb * 32 + F.lane, __builtin_bit_cast(unsigned, mx), RLX_AGENT);
            }
        }
        return;
    } else {
        unsigned char* W1T8 = (unsigned char*)(ws + WS_W1T); unsigned char* WQT8 = (unsigned char*)(ws + WS_WQT); unsigned char* WOT8 = (unsigned char*)(ws + WS_WOT);
        for (int it = gw; it < I_1 + 2 * I_S; it += NGW) {
            const bool iso = it >= I_1 + I_S, isq = it >= I_1 && !iso, sq = it >= I_1; const int r2i = iso ? it - I_1 - I_S : (isq ? it - I_1 : it);
            const int kb = sq ? r2i / 32 : r2i / 200, nb = sq ? r2i % 32 : r2i % 200, n0 = nb * 32, src = sq ? n0 : w1_src(n0);
            const float* Wsrc = iso ? wo : (isq ? wq : w_in); const int ldw = sq ? D : INW;
#pragma unroll 8
            for (int i = 0; i < 32; ++i) { const int kk = 2 * i + (F.lane >> 5); float v = Wsrc[(size_t)(kb * 64 + kk) * ldw + src + (F.lane & 31)]; if (isq) v *= g2[kb * 64 + kk]; scr[kk * 33 + (F.lane & 31)] = v; }
            LDS_WAIT(); asm volatile("" ::: "memory");
            const int n = F.lane >> 1, hf = F.lane & 1;
            const float isc = 127.0f / fmaxf(__builtin_bit_cast(float, __hip_atomic_load(SWMAX + (iso ? NP + D : (isq ? NP : 0)) + n0 + n, RLX_AGENT)), 1e-30f);
            unsigned w[8];
#pragma unroll
            for (int q = 0; q < 8; ++q) { unsigned a4 = 0u;
#pragma unroll
                for (int k = 0; k < 4; ++k) a4 |= (unsigned)((int)__builtin_rintf(scr[(32 * hf + 4 * q + k) * 33 + n] * isc) & 0xff) << (8 * k);
                w[q] = a4; }
            unsigned char* dst = (iso ? WOT8 : (isq ? WQT8 : W1T8)) + (size_t)(n0 + n) * D + kb * 64 + 32 * hf;
            *(GAS v4u*)(dst) = (v4u){w[0], w[1], w[2], w[3]}; *(GAS v4u*)(dst + 16) = (v4u){w[4], w[5], w[6], w[7]};
            LDS_WAIT(); asm volatile("" ::: "memory");
        }

    }
    for (int c = gt; c < 8 * 2 * 128 * 64 / 8; c += NGT) {
        const size_t e0 = (size_t)c * 8; const f32x4 b0 = *(const f32x4*)(skeys + e0), b1 = *(const f32x4*)(skeys + e0 + 4);
        v4u p; p.x = pk2(b0[0], b0[1]); p.y = pk2(b0[2], b0[3]); p.z = pk2(b1[0], b1[1]); p.w = pk2(b1[2], b1[3]);
        *(v4u*)(KEYS + e0) = p;
    }
    for (int c = gt; c < M * 8; c += NGT) {
        const int t = c >> 3, i = c & 7;
        const float inv_freq = i == 0 ? 1.000000000e+00f : i == 1 ? 1.939227432e-01f : i == 2 ? 3.760603070e-02f : i == 3 ? 7.292664610e-03f : i == 4 ? 1.414213562e-03f : i == 5 ? 2.742481884e-04f : i == 6 ? 5.318296098e-05f : 1.031338616e-05f;
        const float angf = (float)pos[t] * inv_freq;
        const double rev = (double)angf * 0.15915494309189535;
        const float fr = (float)(rev - __builtin_rint(rev));
        ROPE[(size_t)t * 16 + i] = __builtin_amdgcn_cosf(fr); ROPE[(size_t)t * 16 + 8 + i] = __builtin_amdgcn_sinf(fr);
    }
    {
        __syncthreads();
        LAS float* wg = (LAS float*)(F.lds + RING_OFF);
        for (int i = F.tid; i < 16 * 1024; i += NTHREADS) { const int c = i & 15, k = i >> 4; wg[c * 1024 + k] = w_in[(size_t)k * INW + 3328 + c]; }
        __syncthreads();
        const float bias = F.lane < 8 ? ibias[F.lane] : (F.lane < 16 ? fbias[F.lane - 8] : 0.f);
        const f32x4 gg0 = *(const f32x4*)(g1 + 4 * F.lane), gg1 = *(const f32x4*)(g1 + 256 + 4 * F.lane), gg2 = *(const f32x4*)(g1 + 512 + 4 * F.lane), gg3 = *(const f32x4*)(g1 + 768 + 4 * F.lane);
        f32x4 nx[4];
        { const GAS f32x4* xr0 = (const GAS f32x4*)(x + (size_t)(gw < M ? gw : 0) * D) + F.lane;
#pragma unroll
          for (int j = 0; j < 4; ++j) nx[j] = xr0[64 * j]; }
        for (int m = gw; m < M; m += NGW) {
            f32x4 v[4]; float s = 0.f;
#pragma unroll
            for (int j = 0; j < 4; ++j) { v[j] = nx[j]; s += (v[j].x * v[j].x + v[j].y * v[j].y) + (v[j].z * v[j].z + v[j].w * v[j].w); }
            { const int mn = (m + NGW < M) ? m + NGW : m; const GAS f32x4* xr = (const GAS f32x4*)(x + (size_t)mn * D) + F.lane;
#pragma unroll
              for (int j = 0; j < 4; ++j) nx[j] = xr[64 * j]; }
            const float r = 1.0f / sqrtf(wave_sum(s) * (1.f / D) + EPS);
            v[0] = v[0] * r * gg0; v[1] = v[1] * r * gg1; v[2] = v[2] * r * gg2; v[3] = v[3] * r * gg3;
            float am = 0.f;
#pragma unroll
            for (int j = 0; j < 4; ++j) am = fmaxf(fmaxf(am, fmaxf(fabsf(v[j].x), fabsf(v[j].y))), fmaxf(fabsf(v[j].z), fabsf(v[j].w)));
            am = fmaxf(wave_max(am), 1e-30f);
            const float isx = 127.0f / am;
            GAS unsigned* o4 = (GAS unsigned*)(XN8 + (size_t)m * D) + F.lane;
#pragma unroll
            for (int j = 0; j < 4; ++j) o4[64 * j] = ((unsigned)((int)__builtin_rintf(v[j].x * isx) & 0xff)) | ((unsigned)((int)__builtin_rintf(v[j].y * isx) & 0xff) << 8) | ((unsigned)((int)__builtin_rintf(v[j].z * isx) & 0xff) << 16) | ((unsigned)((int)__builtin_rintf(v[j].w * isx) & 0xff) << 24);
            if (F.lane == 0) SX[m] = am * (1.0f / 127.0f);
            float mine = 0.f;
#pragma unroll 2
            for (int c = 0; c < 16; ++c) {
                float p = 0.f;
#pragma unroll
                for (int j = 0; j < 4; ++j) { const f32x4 w = *(const LAS f32x4*)(wg + c * 1024 + 256 * j + 4 * F.lane); p += (v[j].x * w.x + v[j].y * w.y) + (v[j].z * w.z + v[j].w * w.w); }
                p = wave_sum(p);
                if (F.lane == c) mine = p;
            }
            if (F.lane < 16) {
                float g = mine + bias; g = GATE_CAP * tanhf(g / GATE_CAP);
                if (F.lane >= 8) g = fminf(g, 0.f) - log1pf(__expf(-fabsf(g)));
                GATES[(size_t)m * 16 + F.lane] = g;
            }
        }
        __syncthreads();
    }
}

typedef float f32x16 __attribute__((ext_vector_type(16)));
typedef unsigned u32x2 __attribute__((ext_vector_type(2)));
constexpr int ATT_KS = 0, ATT_KROW = 144, ATT_VT = 256 * ATT_KROW, ATT_VROW = 520, ATT_LDS = ATT_VT + 64 * ATT_VROW;
constexpr float LOG2E = 1.4426950408889634f;
__device__ __forceinline__ void attn_unit(Frame& F, bf16* ATTC, bf16* PROJ, const float* __restrict__ ROPE, const float* __restrict__ qg, const float* __restrict__ kg, const float* __restrict__ sinks, int unit) {
    const int kvh = unit & 1, j = (unit >> 1) & 31, b = unit >> 6;
    const size_t t0 = (size_t)b * SEQ + (size_t)j * 128;
    LAS unsigned char* Ks = F.lds + ATT_KS; LAS unsigned char* Vt = F.lds + ATT_VT;
    __syncthreads();
    {
        const int p = F.tid & 7, rr = F.tid >> 3;
        float g[8];
#pragma unroll
        for (int e = 0; e < 8; ++e) g[e] = kg[p * 8 + e];
#pragma unroll
        for (int pass = 0; pass < 4; ++pass) {
            const int kk = pass * 64 + rr;
            pg8::u32x4 w = {0u, 0u, 0u, 0u};
            if (j > 0 || kk >= 128) {
                const size_t tok = t0 - 128 + kk;
                float v[8]; pg8::unpack8(*(const pg8::u32x4*)(PROJ + tok * LDP + C_AK + kvh * 64 + p * 8), v);
                float ss = 0.f;
#pragma unroll
                for (int e = 0; e < 8; ++e) ss += v[e] * v[e];
                ss += __shfl_xor(ss, 1); ss += __shfl_xor(ss, 2); ss += __shfl_xor(ss, 4);
                const float r = __builtin_amdgcn_rsqf(ss * (1.0f / 64.0f) + EPS);
#pragma unroll
                for (int e = 0; e < 8; ++e) v[e] = v[e] * r * g[e];
                float pt[8];
#pragma unroll
                for (int e = 0; e < 8; ++e) pt[e] = __shfl_xor(v[e], 1);
                if (p < 2) {
                    const f32x4 c0 = *(const f32x4*)(ROPE + tok * 16), c1 = *(const f32x4*)(ROPE + tok * 16 + 4), s0 = *(const f32x4*)(ROPE + tok * 16 + 8), s1 = *(const f32x4*)(ROPE + tok * 16 + 12);
                    const float sg = p == 0 ? -1.f : 1.f;
#pragma unroll
                    for (int e = 0; e < 4; ++e) { v[e] = v[e] * c0[e] + sg * pt[e] * s0[e]; v[4 + e] = v[4 + e] * c1[e] + sg * pt[4 + e] * s1[e]; }
                }
                w = pg8::pack8(v);
            }
            *(LAS pg8::u32x4*)(Ks + kk * ATT_KROW + p * 16) = w;
        }
    }
    {
        const int kp = F.tid & 127, dg = F.tid >> 7;
        float a[16], c[16];
        if (j > 0 || kp >= 64) {
            const size_t tok = t0 - 128 + 2 * kp;
            const bf16* src = PROJ + tok * LDP + C_AV + kvh * 64 + dg * 16;
            float t8[8];
            pg8::unpack8(*(const pg8::u32x4*)(src), t8);
#pragma unroll
            for (int e = 0; e < 8; ++e) a[e] = t8[e];
            pg8::unpack8(*(const pg8::u32x4*)(src + 8), t8);
#pragma unroll
            for (int e = 0; e < 8; ++e) a[8 + e] = t8[e];
            pg8::unpack8(*(const pg8::u32x4*)(src + LDP), t8);
#pragma unroll
            for (int e = 0; e < 8; ++e) c[e] = t8[e];
            pg8::unpack8(*(const pg8::u32x4*)(src + LDP + 8), t8);
#pragma unroll
            for (int e = 0; e < 8; ++e) c[8 + e] = t8[e];
        } else {
#pragma unroll
            for (int e = 0; e < 16; ++e) { a[e] = 0.f; c[e] = 0.f; }
        }
#pragma unroll
        for (int e = 0; e < 16; ++e) *(LAS unsigned*)(Vt + (dg * 16 + e) * ATT_VROW + kp * 4) = pg8::cvt_pk_bf16(a[e], c[e]);
    }
    __syncthreads();
    const int h = kvh * 8 + F.wave, r = F.lane & 31, hh = F.lane >> 5;
    const float sink2 = sinks[h] * LOG2E;
    float gq[32];
#pragma unroll
    for (int s = 0; s < 4; ++s)
#pragma unroll
        for (int e = 0; e < 8; ++e) gq[s * 8 + e] = qg[16 * s + 8 * hh + e];
#pragma unroll 1
    for (int qi = 0; qi < 4; ++qi) {
        const size_t tok = t0 + 32 * qi + r;
        bf16* qrow = PROJ + tok * LDP + C_AQ + h * 64;
        float qv[32]; float ss = 0.f;
#pragma unroll
        for (int s = 0; s < 4; ++s) { float t8[8]; pg8::unpack8(*(const pg8::u32x4*)(qrow + 16 * s + 8 * hh), t8);
#pragma unroll
            for (int e = 0; e < 8; ++e) { qv[s * 8 + e] = t8[e]; ss += t8[e] * t8[e]; } }
        ss += __shfl_xor(ss, 32);
        const float rq = __builtin_amdgcn_rsqf(ss * (1.0f / 64.0f) + EPS) * (0.125f * LOG2E);
#pragma unroll
        for (int e = 0; e < 32; ++e) qv[e] = qv[e] * rq * gq[e];
        {
            const f32x4 c0 = *(const f32x4*)(ROPE + tok * 16), c1 = *(const f32x4*)(ROPE + tok * 16 + 4), s0 = *(const f32x4*)(ROPE + tok * 16 + 8), s1 = *(const f32x4*)(ROPE + tok * 16 + 12);
            const float sg = hh == 0 ? -1.f : 1.f;
            float pt[8];
#pragma unroll
            for (int e = 0; e < 8; ++e) pt[e] = __shfl_xor(qv[e], 32);
#pragma unroll
            for (int e = 0; e < 4; ++e) { qv[e] = qv[e] * c0[e] + sg * pt[e] * s0[e]; qv[4 + e] = qv[4 + e] * c1[e] + sg * pt[4 + e] * s1[e]; }
        }
        bf16x8 qf[4];
#pragma unroll
        for (int s = 0; s < 4; ++s) { float t8[8];
#pragma unroll
            for (int e = 0; e < 8; ++e) t8[e] = qv[s * 8 + e];
            qf[s] = __builtin_bit_cast(bf16x8, pg8::pack8(t8)); }
        f32x16 S[5];
        float mx = sink2;
#pragma unroll
        for (int ii = 0; ii < 5; ++ii) {
            const int jk = qi + ii;
            f32x16 acc = {};
            const LAS unsigned char* kb = Ks + (32 * jk + r) * ATT_KROW + hh * 16;
#pragma unroll
            for (int s = 0; s < 4; ++s) acc = __builtin_amdgcn_mfma_f32_32x32x16_bf16(*(const LAS bf16x8*)(kb + s * 32), qf[s], acc, 0, 0, 0);
            const bool dead = (j == 0 && jk < 4);
#pragma unroll
            for (int i = 0; i < 16; ++i) {
                const int krow = (i & 3) + 8 * (i >> 2) + 4 * hh;
                bool ok = !dead;
                if (ii == 0) ok = ok && (krow > r);
                if (ii == 4) ok = ok && (krow <= r);
                acc[i] = ok ? acc[i] : -INFINITY;
                mx = fmaxf(mx, acc[i]);
            }
            S[ii] = acc;
        }
        mx = fmaxf(mx, __shfl_xor(mx, 32));
        float den = 0.f;
#pragma unroll
        for (int ii = 0; ii < 5; ++ii)
#pragma unroll
            for (int i = 0; i < 16; ++i) { const float pv = __builtin_amdgcn_exp2f(S[ii][i] - mx); S[ii][i] = pv; den += pv; }
        den += __shfl_xor(den, 32);
        den += __builtin_amdgcn_exp2f(sink2 - mx);
        f32x16 o[2] = {};
#pragma unroll
        for (int ii = 0; ii < 5; ++ii) {
            const int jk = qi + ii;
#pragma unroll
            for (int sp = 0; sp < 2; ++sp) {
                float t8[8];
#pragma unroll
                for (int e = 0; e < 8; ++e) t8[e] = S[ii][8 * sp + e];
                const bf16x8 pb = __builtin_bit_cast(bf16x8, pg8::pack8(t8));
                const int kbase = 32 * jk + 16 * sp + 4 * hh;
#pragma unroll
                for (int dt = 0; dt < 2; ++dt) {
                    const LAS unsigned char* vp = Vt + (32 * dt + r) * ATT_VROW + kbase * 2;
                    const u32x2 lo = *(const LAS u32x2*)(vp), hi2 = *(const LAS u32x2*)(vp + 16);
                    const pg8::u32x4 av = {lo.x, lo.y, hi2.x, hi2.y};
                    o[dt] = __builtin_amdgcn_mfma_f32_32x32x16_bf16(__builtin_bit_cast(bf16x8, av), pb, o[dt], 0, 0, 0);
                }
            }
        }
        const float inv = __builtin_amdgcn_rcpf(den);
#pragma unroll
        for (int dt = 0; dt < 2; ++dt)
#pragma unroll
            for (int g4 = 0; g4 < 4; ++g4) {
                u32x2 w; w.x = pg8::cvt_pk_bf16(o[dt][4 * g4] * inv, o[dt][4 * g4 + 1] * inv); w.y = pg8::cvt_pk_bf16(o[dt][4 * g4 + 2] * inv, o[dt][4 * g4 + 3] * inv);
                *(u32x2*)(ATTC + tok * 1024 + h * 64 + 32 * dt + 8 * g4 + 4 * hh) = w;
            }
    }
}


constexpr int ML_ROW = 144;
constexpr int ML_QS = 0, ML_KS = ML_QS + 64 * ML_ROW, ML_KT = ML_KS + 64 * ML_ROW, ML_VT = ML_KT + 64 * ML_ROW, ML_AA = ML_VT + 128 * ML_ROW, ML_NN = ML_AA + 256, ML_HB = ML_NN + 512;
constexpr int ML_HROW = 528, ML_GN = ML_HB + 64 * ML_HROW, ML_LDS = ML_GN + 512;
__device__ __forceinline__ void mlstm_unit(Frame& F, bf16* PROJ, const float* __restrict__ GATES, const float* __restrict__ mog, int unit) {
    const int b = unit >> 3, h = unit & 7;
    const int tid = F.tid, lane = F.lane, r = lane & 31, hh = lane >> 5, vi = F.wave >> 1, ti = F.wave & 1;
    LAS unsigned char* L = F.lds;
    LAS float* AA = (LAS float*)(L + ML_AA); LAS float* NN = (LAS float*)(L + ML_NN);
    const size_t tb = (size_t)b * SEQ;
    const int n_row = tid >> 3, n_pc = tid & 7;
    const int rp = lane & 31;
    const int kt_d0 = 8 * F.wave + 4 * hh;
    const int vt_v0 = 16 * F.wave + 8 * hh;
    const int e_t = tid >> 3, e_sub = tid & 7;
    f32x16 C[2] = {};
    float m2 = 0.f;
    __syncthreads();
    if (tid < 128) { NN[tid] = 0.f; ((LAS float*)(L + ML_GN))[tid] = mog[h * 128 + tid]; }
    pg8::u32x4 pq, pk, pv0, pv1, pmo0; u32x2 pkt0, pkt1; float pgi, pgf;
#define ML_PREFETCH(c) do { const size_t tc = tb + (size_t)(c) * 64; \
        pq = *(const pg8::u32x4*)(PROJ + (tc + n_row) * LDP + C_MQ + h * 64 + n_pc * 8); \
        pk = *(const pg8::u32x4*)(PROJ + (tc + n_row) * LDP + C_MK + h * 64 + n_pc * 8); \
        pkt0 = *(const u32x2*)(PROJ + (tc + 2 * rp) * LDP + C_MK + h * 64 + kt_d0); pkt1 = *(const u32x2*)(PROJ + (tc + 2 * rp + 1) * LDP + C_MK + h * 64 + kt_d0); \
        pv0 = *(const pg8::u32x4*)(PROJ + (tc + 2 * rp) * LDP + C_MV + h * 128 + vt_v0); pv1 = *(const pg8::u32x4*)(PROJ + (tc + 2 * rp + 1) * LDP + C_MV + h * 128 + vt_v0); \
        pgi = GATES[(tc + lane) * 16 + h]; pgf = GATES[(tc + lane) * 16 + 8 + h]; } while (0)
    ML_PREFETCH(0);
#pragma unroll 1
    for (int c = 0; c < 64; ++c) {
        const size_t tc = tb + (size_t)c * 64;
        const float i2 = pgi * LOG2E;
        float b2 = pgf * LOG2E;
        DPP_SCAN(b2, 0.f, DPP_ADD);
        const float a2 = i2 - b2;
        float pm = a2;
        DPP_SCAN(pm, -INFINITY, DPP_MAX);
        const float Mt2 = fmaxf(m2, pm);
        const float M63 = lane_bcast(Mt2, 63), b63 = lane_bcast(b2, 63);
        const float wint_l = __builtin_amdgcn_exp2f(m2 - Mt2), emt_l = __builtin_amdgcn_exp2f(-(b2 + Mt2));
        const float decay = __builtin_amdgcn_exp2f(m2 - M63);
        const float ws0 = __builtin_amdgcn_exp2f(__shfl(a2, 2 * rp) - M63), ws1 = __builtin_amdgcn_exp2f(__shfl(a2, 2 * rp + 1) - M63);
        const float Mt_t = __shfl(Mt2, 32 * ti + r), wint_t = __shfl(wint_l, 32 * ti + r), emt_t = __shfl(emt_l, 32 * ti + r);
        m2 = b63 + M63;
        if (F.wave == 0) AA[lane] = a2;
        *(LAS pg8::u32x4*)(L + ML_QS + n_row * ML_ROW + n_pc * 16) = pq;
        *(LAS pg8::u32x4*)(L + ML_KS + n_row * ML_ROW + n_pc * 16) = pk;
        {
            const float k0[4] = {pg8::bf_lo(pkt0.x), pg8::bf_hi(pkt0.x), pg8::bf_lo(pkt0.y), pg8::bf_hi(pkt0.y)}, k1[4] = {pg8::bf_lo(pkt1.x), pg8::bf_hi(pkt1.x), pg8::bf_lo(pkt1.y), pg8::bf_hi(pkt1.y)};
#pragma unroll
            for (int e = 0; e < 4; ++e) *(LAS unsigned*)(L + ML_KT + (kt_d0 + e) * ML_ROW + rp * 4) = pg8::cvt_pk_bf16(k0[e] * ws0, k1[e] * ws1);
            const unsigned w0[4] = {pv0.x, pv0.y, pv0.z, pv0.w}, w1[4] = {pv1.x, pv1.y, pv1.z, pv1.w};
#pragma unroll
            for (int e = 0; e < 4; ++e) {
                *(LAS unsigned*)(L + ML_VT + (vt_v0 + 2 * e) * ML_ROW + rp * 4) = (w0[e] & 0xffffu) | (w1[e] << 16);
                *(LAS unsigned*)(L + ML_VT + (vt_v0 + 2 * e + 1) * ML_ROW + rp * 4) = (w0[e] >> 16) | (w1[e] & 0xffff0000u);
            }
        }
        if (c > 0) { const size_t etc = tc - 64;
        {
            const LAS f32x4* hp = (const LAS f32x4*)(L + ML_HB + e_t * ML_HROW + e_sub * 64);
            float hv[16]; float ss = 0.f;
#pragma unroll
            for (int q4 = 0; q4 < 4; ++q4) { const f32x4 x4 = hp[q4];
#pragma unroll
                for (int e = 0; e < 4; ++e) { hv[4 * q4 + e] = x4[e]; ss += x4[e] * x4[e]; } }
            ss = sum8_dpp(ss, lane);
            const float rr = __builtin_amdgcn_rsqf(ss * (1.0f / 128.0f) + EPS);
            float mo[16]; { const unsigned w4[4] = {pmo0.x, pmo0.y, pmo0.z, pmo0.w};
#pragma unroll
                for (int q4 = 0; q4 < 4; ++q4)
#pragma unroll
                    for (int e = 0; e < 4; ++e) mo[4 * q4 + e] = (float)((w4[q4] >> (8 * e)) & 0xffu) * (1.0f / 255.0f); }
            float gain[16];
#pragma unroll
            for (int q4 = 0; q4 < 4; ++q4) { const f32x4 g4 = *(const LAS f32x4*)(L + ML_GN + (16 * e_sub + 4 * q4) * 4); gain[4 * q4] = g4[0]; gain[4 * q4 + 1] = g4[1]; gain[4 * q4 + 2] = g4[2]; gain[4 * q4 + 3] = g4[3]; }
            float o8[8];
#pragma unroll
            for (int e = 0; e < 8; ++e) o8[e] = hv[e] * rr * gain[e] * mo[e];
            bf16* dst = PROJ + (etc + e_t) * LDP + C_HMN + h * 128 + 16 * e_sub;
            *(pg8::u32x4*)(dst) = pg8::pack8(o8);
#pragma unroll
            for (int e = 0; e < 8; ++e) o8[e] = hv[8 + e] * rr * gain[8 + e] * mo[8 + e];
            *(pg8::u32x4*)(dst + 8) = pg8::pack8(o8);
        }
        }
        pmo0 = *(const pg8::u32x4*)((const unsigned char*)(PROJ + (tc + e_t) * LDP + C_MO) + h * 128 + 16 * e_sub);
        if (c + 1 < 64) ML_PREFETCH(c + 1);
        __syncthreads();
        const LAS float* ncur = NN + (c & 1) * 64; LAS float* nnxt = NN + ((c + 1) & 1) * 64;
        bf16x8 qf[4], kf[4], qb[2][2];
#pragma unroll
        for (int s4 = 0; s4 < 4; ++s4) qf[s4] = *(const LAS bf16x8*)(L + ML_QS + (32 * ti + r) * ML_ROW + s4 * 32 + hh * 16);
#pragma unroll
        for (int s4 = 0; s4 < 4; ++s4) kf[s4] = *(const LAS bf16x8*)(L + ML_KS + r * ML_ROW + s4 * 32 + hh * 16);
#pragma unroll
        for (int dt = 0; dt < 2; ++dt)
#pragma unroll
            for (int sp = 0; sp < 2; ++sp) {
                const LAS unsigned char* qp = L + ML_QS + (32 * ti + r) * ML_ROW + (32 * dt + 16 * sp + 4 * hh) * 2;
                const u32x2 lo = *(const LAS u32x2*)(qp), hi2 = *(const LAS u32x2*)(qp + 16);
                qb[dt][sp] = __builtin_bit_cast(bf16x8, (pg8::u32x4){lo.x, lo.y, hi2.x, hi2.y});
            }
        float nq = 0.f;
        {
            f32x4 nv[8];
#pragma unroll
            for (int s4 = 0; s4 < 4; ++s4) { nv[2 * s4] = *(const LAS f32x4*)(ncur + 16 * s4 + 8 * hh); nv[2 * s4 + 1] = *(const LAS f32x4*)(ncur + 16 * s4 + 8 * hh + 4); }
#pragma unroll
            for (int s4 = 0; s4 < 4; ++s4) {
                float q8[8]; pg8::unpack8(__builtin_bit_cast(pg8::u32x4, qf[s4]), q8);
#pragma unroll
                for (int e = 0; e < 4; ++e) nq += q8[e] * nv[2 * s4][e] + q8[4 + e] * nv[2 * s4 + 1][e];
            }
            nq += __shfl_xor(nq, 32);
        }
        bf16x8 ca[2][2];
#pragma unroll
        for (int dt = 0; dt < 2; ++dt)
#pragma unroll
            for (int sp = 0; sp < 2; ++sp) { float t8[8];
#pragma unroll
                for (int e = 0; e < 8; ++e) t8[e] = C[dt][8 * sp + e];
                ca[dt][sp] = __builtin_bit_cast(bf16x8, pg8::pack8(t8)); }
#pragma unroll
        for (int dt = 0; dt < 2; ++dt)
#pragma unroll
            for (int i = 0; i < 16; ++i) C[dt][i] *= decay;
        f32x16 num = {};
#pragma unroll
        for (int dt = 0; dt < 2; ++dt)
#pragma unroll
            for (int sp = 0; sp < 2; ++sp) num = __builtin_amdgcn_mfma_f32_32x32x16_bf16(ca[dt][sp], qb[dt][sp], num, 0, 0, 0);
        f32x16 P[2] = {};
#pragma unroll
        for (int s4 = 0; s4 < 4; ++s4) P[0] = __builtin_amdgcn_mfma_f32_32x32x16_bf16(kf[s4], qf[s4], P[0], 0, 0, 0);
        if (ti == 1) {
#pragma unroll
            for (int s4 = 0; s4 < 4; ++s4) kf[s4] = *(const LAS bf16x8*)(L + ML_KS + (32 + r) * ML_ROW + s4 * 32 + hh * 16);
#pragma unroll
            for (int s4 = 0; s4 < 4; ++s4) P[1] = __builtin_amdgcn_mfma_f32_32x32x16_bf16(kf[s4], qf[s4], P[1], 0, 0, 0);
        }
        bf16x8 vt[4];
#pragma unroll
        for (int s4 = 0; s4 < 4; ++s4) vt[s4] = *(const LAS bf16x8*)(L + ML_VT + (32 * vi + r) * ML_ROW + s4 * 32 + hh * 16);
#pragma unroll
        for (int dt = 0; dt < 2; ++dt) {
            bf16x8 kt[4];
#pragma unroll
            for (int s4 = 0; s4 < 4; ++s4) kt[s4] = *(const LAS bf16x8*)(L + ML_KT + (32 * dt + r) * ML_ROW + s4 * 32 + hh * 16);
#pragma unroll
            for (int s4 = 0; s4 < 4; ++s4) C[dt] = __builtin_amdgcn_mfma_f32_32x32x16_bf16(kt[s4], vt[s4], C[dt], 0, 0, 0);
        }
        f32x4 av[2][4];
#pragma unroll
        for (int st = 0; st < 2; ++st)
#pragma unroll
            for (int g = 0; g < 4; ++g) av[st][g] = *(const LAS f32x4*)(AA + 32 * (st <= ti ? st : 0) + 8 * g + 4 * hh);
        float dsum = 0.f;
        if (ti == 1) {
#pragma unroll
            for (int g = 0; g < 4; ++g)
#pragma unroll
                for (int e = 0; e < 4; ++e) { const float pvv = P[0][4 * g + e] * __builtin_amdgcn_exp2f(av[0][g][e] - Mt_t); P[0][4 * g + e] = pvv; dsum += pvv; }
        }
        {
            f32x16 D0 = ti == 1 ? P[1] : P[0];
#pragma unroll
            for (int g = 0; g < 4; ++g)
#pragma unroll
                for (int e = 0; e < 4; ++e) {
                    const float a = ti == 1 ? av[1][g][e] : av[0][g][e];
                    const float w = (8 * g + 4 * hh + e <= r) ? __builtin_amdgcn_exp2f(a - Mt_t) : 0.f;
                    const float pvv = D0[4 * g + e] * w; D0[4 * g + e] = pvv; dsum += pvv;
                }
            if (ti == 1) P[1] = D0; else P[0] = D0;
        }
        dsum += __shfl_xor(dsum, 32);
#pragma unroll
        for (int i = 0; i < 16; ++i) num[i] *= wint_t;
        bf16x8 va[2][2];
#pragma unroll
        for (int st = 0; st < 2; ++st)
#pragma unroll
            for (int sp = 0; sp < 2; ++sp) {
                const LAS unsigned char* vp = L + ML_VT + (32 * vi + r) * ML_ROW + (32 * (st <= ti ? st : 0) + 16 * sp + 4 * hh) * 2;
                const u32x2 lo = *(const LAS u32x2*)(vp), hi2 = *(const LAS u32x2*)(vp + 16);
                va[st][sp] = __builtin_bit_cast(bf16x8, (pg8::u32x4){lo.x, lo.y, hi2.x, hi2.y});
            }
#pragma unroll
        for (int st = 0; st < 2; ++st) {
            if (st <= ti) {
#pragma unroll
                for (int sp = 0; sp < 2; ++sp) {
                    float t8[8];
#pragma unroll
                    for (int e = 0; e < 8; ++e) t8[e] = P[st][8 * sp + e];
                    num = __builtin_amdgcn_mfma_f32_32x32x16_bf16(va[st][sp], __builtin_bit_cast(bf16x8, pg8::pack8(t8)), num, 0, 0, 0);
                }
            }
        }
        const float den = dsum + wint_t * nq;
        const float inv = __builtin_amdgcn_rcpf(fmaxf(fabsf(den), emt_t));
#pragma unroll
        for (int g = 0; g < 4; ++g) {
            const f32x4 hv = {num[4 * g] * inv, num[4 * g + 1] * inv, num[4 * g + 2] * inv, num[4 * g + 3] * inv};
            *(LAS f32x4*)(L + ML_HB + (32 * ti + r) * ML_HROW + (32 * vi + 8 * g + 4 * hh) * 4) = hv;
        }
        {
            const int d = tid >> 3, sub = tid & 7;
            float k8[8]; pg8::unpack8(*(const LAS pg8::u32x4*)(L + ML_KT + d * ML_ROW + sub * 16), k8);
            float s = ((k8[0] + k8[1]) + (k8[2] + k8[3])) + ((k8[4] + k8[5]) + (k8[6] + k8[7]));
            s = sum8_dpp(s, lane);
            if (sub == 0) nnxt[d] = decay * ncur[d] + s;
        }
        __syncthreads();
    }
    __syncthreads();
    { const size_t etc = tb + 63 * 64;
        {
            const LAS f32x4* hp = (const LAS f32x4*)(L + ML_HB + e_t * ML_HROW + e_sub * 64);
            float hv[16]; float ss = 0.f;
#pragma unroll
            for (int q4 = 0; q4 < 4; ++q4) { const f32x4 x4 = hp[q4];
#pragma unroll
                for (int e = 0; e < 4; ++e) { hv[4 * q4 + e] = x4[e]; ss += x4[e] * x4[e]; } }
            ss = sum8_dpp(ss, lane);
            const float rr = __builtin_amdgcn_rsqf(ss * (1.0f / 128.0f) + EPS);
            float mo[16]; { const unsigned w4[4] = {pmo0.x, pmo0.y, pmo0.z, pmo0.w};
#pragma unroll
                for (int q4 = 0; q4 < 4; ++q4)
#pragma unroll
                    for (int e = 0; e < 4; ++e) mo[4 * q4 + e] = (float)((w4[q4] >> (8 * e)) & 0xffu) * (1.0f / 255.0f); }
            float gain[16];
#pragma unroll
            for (int q4 = 0; q4 < 4; ++q4) { const f32x4 g4 = *(const LAS f32x4*)(L + ML_GN + (16 * e_sub + 4 * q4) * 4); gain[4 * q4] = g4[0]; gain[4 * q4 + 1] = g4[1]; gain[4 * q4 + 2] = g4[2]; gain[4 * q4 + 3] = g4[3]; }
            float o8[8];
#pragma unroll
            for (int e = 0; e < 8; ++e) o8[e] = hv[e] * rr * gain[e] * mo[e];
            bf16* dst = PROJ + (etc + e_t) * LDP + C_HMN + h * 128 + 16 * e_sub;
            *(pg8::u32x4*)(dst) = pg8::pack8(o8);
#pragma unroll
            for (int e = 0; e < 8; ++e) o8[e] = hv[8 + e] * rr * gain[8 + e] * mo[8 + e];
            *(pg8::u32x4*)(dst + 8) = pg8::pack8(o8);
        }
    }
#undef ML_PREFETCH
}

typedef __bf16 bf16x2_t __attribute__((ext_vector_type(2)));
__device__ __forceinline__ float dot2bf(unsigned a, unsigned b, float c) { return __builtin_amdgcn_fdot2_f32_bf16(__builtin_bit_cast(bf16x2_t, a), __builtin_bit_cast(bf16x2_t, b), c, false); }
__device__ __forceinline__ float dot8(const pg8::u32x4 a, const pg8::u32x4 b, float c) { c = dot2bf(a.x, b.x, c); c = dot2bf(a.y, b.y, c); c = dot2bf(a.z, b.z, c); return dot2bf(a.w, b.w, c); }
__device__ __forceinline__ float gelu_erf(float v) {
    const float av = fabsf(v), t = __builtin_amdgcn_rcpf(av * 0.2316418882f + 1.0f);
    float q = t * 0.5307027145f + (-0.7265760135f); q = q * t + 0.7107068705f; q = q * t + (-0.142248368f); q = q * t + 0.127414796f; q = q * t;
    const float e = __builtin_amdgcn_exp2f((v * v) * (-0.72134752044f));
    const float m = v * (q * e);
    return v < 0.f ? m : v - m;
}

__device__ __forceinline__ int f2ord(float x) { const int u = __builtin_bit_cast(int, x); return u ^ ((u >> 31) & 0x7FFFFFFF); }
__device__ __forceinline__ float ord2f(int k) { return __builtin_bit_cast(float, k ^ ((k >> 31) & 0x7FFFFFFF)); }
#define RT_CE(a, b) do { const int _hi = max((a), (b)), _lo = min((a), (b)); (a) = _hi; (b) = _lo; } while (0)
__device__ __forceinline__ void sort16_desc(int (&v)[16]) {
#pragma unroll
    for (int k = 2; k <= 16; k <<= 1)
#pragma unroll
        for (int j = k >> 1; j > 0; j >>= 1)
#pragma unroll
            for (int i = 0; i < 16; ++i) { const int l = i ^ j; if (l > i) { if ((i & k) == 0) RT_CE(v[i], v[l]); else RT_CE(v[l], v[i]); } }
}
__device__ __forceinline__ void merge16_desc(int (&a)[16], const int (&b)[16]) {
#pragma unroll
    for (int i = 0; i < 16; ++i) a[i] = max(a[i], b[15 - i]);
#pragma unroll
    for (int j = 8; j > 0; j >>= 1)
#pragma unroll
        for (int i = 0; i < 16; ++i) { const int l = i ^ j; if (l > i) RT_CE(a[i], a[l]); }
}
constexpr int RT_LROW = 33;
struct RouteQ { bf16x8 q[2][4]; };
__device__ __forceinline__ void route_load_q(RouteQ& Q, const bf16* __restrict__ PROJ, int tt, int h, int lane) {
    const int r = lane & 31, hh = lane >> 5;
    const bf16* qrow = PROJ + ((size_t)tt * 32 + r) * LDP + C_QB + h * 128 + 8 * hh;
#pragma unroll
    for (int p = 0; p < 2; ++p)
#pragma unroll
        for (int s = 0; s < 4; ++s) Q.q[p][s] = *(const bf16x8*)(qrow + p * 64 + 16 * s);
}
constexpr int RT_KEYS_OFF = 8 * 64 * RT_LROW * 4, RT_KROW = 144;
__device__ __forceinline__ void route_unit(Frame& F, const RouteQ& Q, int* __restrict__ IDX, float* __restrict__ GATE, int tt, int h) {
    const int lane = (int)__builtin_amdgcn_mbcnt_hi(~0u, __builtin_amdgcn_mbcnt_lo(~0u, 0u)), r = lane & 31, hh = lane >> 5;
    const size_t tok = (size_t)tt * 32 + r;
    LAS int* my = (LAS int*)(F.lds + F.wave * (64 * RT_LROW * 4)) + lane * RT_LROW;
    int top[2][16];
#pragma unroll
    for (int p = 0; p < 2; ++p) {
        bf16x8 qf[4];
#pragma unroll
        for (int s = 0; s < 4; ++s) qf[s] = Q.q[p][s];
        const LAS unsigned char* kb = F.lds + RT_KEYS_OFF + (p * 128 + r) * RT_KROW + 16 * hh;
        int run[16];
#pragma unroll
        for (int kt = 0; kt < 4; ++kt) {
            f32x16 acc = {};
#pragma unroll
            for (int s = 0; s < 4; ++s) acc = __builtin_amdgcn_mfma_f32_32x32x16_bf16(*(const LAS bf16x8*)(kb + kt * 32 * RT_KROW + 32 * s), qf[s], acc, 0, 0, 0);
            int g[16];
            int hh4 = 4 * hh; asm volatile("" : "+v"(hh4));
#pragma unroll
            for (int i = 0; i < 16; ++i) { const int k0 = 127 - (32 * kt + (i & 3) + 8 * (i >> 2)); g[i] = ((f2ord(acc[i]) & ~0x7F) | k0) ^ hh4; }
            sort16_desc(g);
            if (kt == 0) {
#pragma unroll
                for (int i = 0; i < 16; ++i) run[i] = g[i];
            } else merge16_desc(run, g);
            __builtin_amdgcn_sched_barrier(0);
        }
        {
            int other[16];
#pragma unroll
            for (int i = 0; i < 16; ++i) other[i] = __shfl_xor(run[i], 32);
            merge16_desc(run, other);
        }
#pragma unroll
        for (int i = 0; i < 16; ++i) { top[p][i] = run[i]; my[p * 16 + i] = 127 - (run[i] & 0x7F); }
        asm volatile("" ::: "memory"); __builtin_amdgcn_sched_barrier(0);
    }
    int c[4][16];
    {
        float fa[16], fb[16];
#pragma unroll
        for (int i = 0; i < 16; ++i) { fa[i] = ord2f(top[0][i] & ~0x7F); fb[i] = ord2f(top[1][i] & ~0x7F); }
#define RT_CAND(i, j) ((f2ord(fa[i] + fb[j]) & ~0xFF) | (255 - ((i) * 16 + (j))))
#pragma unroll
        for (int j = 0; j < 16; ++j) c[0][j] = RT_CAND(0, j);
#pragma unroll
        for (int j = 0; j < 8; ++j) { c[1][j] = RT_CAND(1, j); c[1][8 + j] = RT_CAND(15 - j, 0); }
        c[2][0] = RT_CAND(2, 0); c[2][1] = RT_CAND(2, 1); c[2][2] = RT_CAND(2, 2); c[2][3] = RT_CAND(2, 3); c[2][4] = RT_CAND(2, 4);
        c[2][5] = RT_CAND(3, 0); c[2][6] = RT_CAND(3, 1); c[2][7] = RT_CAND(3, 2); c[2][8] = RT_CAND(3, 3);
        c[2][9] = RT_CAND(4, 0); c[2][10] = RT_CAND(4, 1); c[2][11] = RT_CAND(4, 2);
        c[2][12] = RT_CAND(5, 0); c[2][13] = RT_CAND(5, 1); c[2][14] = RT_CAND(6, 0); c[2][15] = RT_CAND(6, 1);
        c[3][0] = RT_CAND(7, 0); c[3][1] = RT_CAND(7, 1);
#pragma unroll
        for (int j = 2; j < 16; ++j) c[3][j] = (int)0x80000000;
#undef RT_CAND
    }
#pragma unroll
    for (int j = 8; j > 0; j >>= 1)
#pragma unroll
        for (int i = 0; i < 16; ++i) { const int l = i ^ j; if (l > i) RT_CE(c[1][i], c[1][l]); }
    __builtin_amdgcn_sched_barrier(0);
    sort16_desc(c[2]); __builtin_amdgcn_sched_barrier(0);
    merge16_desc(c[0], c[1]); __builtin_amdgcn_sched_barrier(0); merge16_desc(c[2], c[3]); __builtin_amdgcn_sched_barrier(0); merge16_desc(c[0], c[2]); __builtin_amdgcn_sched_barrier(0);
    float ev[16]; float sum = 0.f; const float v0 = ord2f(c[0][0] & ~0xFF);
#pragma unroll
    for (int k = 0; k < 16; ++k) { ev[k] = __expf(ord2f(c[0][k] & ~0xFF) - v0); sum += ev[k]; }
    const float inv = __builtin_amdgcn_rcpf(sum);
    asm volatile("s_waitcnt lgkmcnt(0)" ::: "memory");
    int oi[8]; float og[8];
#pragma unroll
    for (int k = 0; k < 8; ++k) {
        const int cc = hh ? c[0][8 + k] : c[0][k]; const float e = hh ? ev[8 + k] : ev[k];
        const int pos = 255 - (cc & 0xFF);
        oi[k] = my[pos >> 4] * 128 + my[16 + (pos & 15)]; og[k] = e * inv;
    }
    unsigned* ip = (unsigned*)IDX + tok * 128 + 2 * h + hh;
#pragma unroll
    for (int k = 0; k < 8; ++k) ip[16 * k] = (unsigned)oi[k] | (f2bf(og[k]) << 16);
}

constexpr int C_XQ = 3072;
struct QRow { pg8::u32x4 v[2]; float sq; };
__device__ __forceinline__ QRow quantize_load(const bf16* __restrict__ PROJ, const float* __restrict__ SSQ, int t, int lane) {
    const pg8::u32x4* xr = (const pg8::u32x4*)(PROJ + (size_t)t * LDP + C_X1B + 16 * lane); QRow q;
    q.v[0] = xr[0]; q.v[1] = xr[1];
    q.sq = SSQ[(size_t)t * 16 + (lane & 15)]; return q;
}
__device__ __forceinline__ void quantize_row(const QRow& q, bf16* __restrict__ PROJ, float* __restrict__ XDQ, int t, int lane) {
    float xv[16];
#pragma unroll
    for (int j = 0; j < 2; ++j) { float t8[8]; pg8::unpack8(q.v[j], t8);
#pragma unroll
        for (int k = 0; k < 8; ++k) xv[8 * j + k] = t8[k]; }
    float am = 0.f;
#pragma unroll
    for (int k = 0; k < 16; ++k) am = fmaxf(am, fabsf(xv[k]));
    am = fmaxf(wave_max(am), 1e-30f);
    const float isx = 127.0f / am;
    unsigned xq[4];
#pragma unroll
    for (int qq = 0; qq < 4; ++qq) { unsigned a4 = 0u;
#pragma unroll
        for (int k = 0; k < 4; ++k) a4 |= (unsigned)((int)__builtin_rintf(xv[4 * qq + k] * isx) & 0xff) << (8 * k);
        xq[qq] = a4; }
    *(pg8::u32x4*)((unsigned char*)(PROJ + (size_t)t * LDP + C_XQ) + 16 * lane) = (pg8::u32x4){xq[0], xq[1], xq[2], xq[3]};
    float tot = q.sq; tot += __shfl_xor(tot, 1); tot += __shfl_xor(tot, 2); tot += __shfl_xor(tot, 4); tot += __shfl_xor(tot, 8);
    if (lane == 0) XDQ[t] = __builtin_amdgcn_rsqf(tot * (1.0f / 1024.0f) + EPS) * am * (1.0f / 127.0f);
}
constexpr int DN_TOK_BYTES = 512 + 1024 + 16, DN_BATCH = 8, DN_MERGE = 4, DN_WAVE_BYTES = DN_BATCH * DN_TOK_BYTES + DN_MERGE * 256;
__device__ __forceinline__ void down_rows(pg8::u32x4 (&R)[8], pg8::u32x4 (&X)[8], const LAS unsigned short* LP, const LAS unsigned char* st0, int g, int n, int lane, const unsigned char* __restrict__ DOWNP) {
    const int j = 8 * g + (lane >> 3);
    const unsigned idx = LP[j < n ? j : 0];
    const LAS unsigned char* sp = st0 + (idx >> 7) * DN_TOK_BYTES;
    const unsigned w = *(const LAS unsigned*)(sp + (idx & 127u) * 4u);
    const unsigned char* rp = DOWNP + ((w & 0x7ffu) << 10) + 16u * (unsigned)(lane & 7);
#pragma unroll
    for (int c = 0; c < 8; ++c) R[c] = *(const pg8::u32x4*)(rp + 128 * c);
    const LAS unsigned char* xs = sp + 512 + 16 * (lane & 7);
#pragma unroll
    for (int c = 0; c < 8; ++c) X[c] = *(const LAS pg8::u32x4*)(xs + 128 * c);
}
__device__ __forceinline__ int down_dot(const pg8::u32x4 (&R)[8], const pg8::u32x4 (&xq)[8]) {
    int a = 0;
#pragma unroll
    for (int c = 0; c < 8; ++c) { a = __builtin_amdgcn_sdot4((int)xq[c].x, (int)R[c].x, a, false); a = __builtin_amdgcn_sdot4((int)xq[c].y, (int)R[c].y, a, false); a = __builtin_amdgcn_sdot4((int)xq[c].z, (int)R[c].z, a, false); a = __builtin_amdgcn_sdot4((int)xq[c].w, (int)R[c].w, a, false); }
    a += __builtin_amdgcn_update_dpp(0, a, 0xB1, 0xf, 0xf, true);
    a += __builtin_amdgcn_update_dpp(0, a, 0x4E, 0xf, 0xf, true);
    const int up4 = __builtin_amdgcn_update_dpp(0, a, 0x104, 0xf, 0xf, true), dn4 = __builtin_amdgcn_update_dpp(0, a, 0x114, 0xf, 0xf, true);
    return a + ((__builtin_amdgcn_mbcnt_hi(~0u, __builtin_amdgcn_mbcnt_lo(~0u, 0u)) & 4u) ? dn4 : up4);
}
__device__ __forceinline__ void down_finish(int mine, const LAS unsigned short* LP, const LAS unsigned char* st0, const LAS float* LSD, const LAS float* LSU, int gbase, int n, int t0, int nw, int lane, unsigned* __restrict__ IC) {
    const int j = 8 * (gbase + (lane & 7)) + (lane >> 3);
    if (j < n) {
        const unsigned idx = LP[j], tok = idx >> 7, pos = idx & 127u;
        const LAS unsigned char* sp = st0 + tok * DN_TOK_BYTES;
        const unsigned w = *(const LAS unsigned*)(sp + pos * 4u), row = w & 0xffffu;
        const float gate = __builtin_bit_cast(float, w & 0xffff0000u), sd = LSD[row & 0x7ffu], su = LSU[row & 0x7ffu], dq = *(const LAS float*)(sp + 1536);
        const float s = (float)mine * dq * sd;
        IC[(size_t)(t0 + (int)tok * nw) * 128 + pos] = row | (f2bf(gate * su * gelu_erf(s)) << 16);
    }
}
__device__ __forceinline__ void down_process(const LAS unsigned char* st0, int t0, int nw, int ntok, int p, int lane, LAS unsigned short* LP, const LAS float* LSD, const LAS float* LSU, const unsigned char* __restrict__ DOWNP, unsigned* __restrict__ IC) {
    int n = 0;
#pragma unroll
    for (int k = 0; k < DN_MERGE; ++k) {
        const LAS unsigned* sk = (const LAS unsigned*)(st0 + k * DN_TOK_BYTES);
        const unsigned a0 = sk[lane], a1 = sk[64 + lane];
        const bool s0 = k < ntok && (int)((a0 & 0xffffu) >> 11) == p, s1 = k < ntok && (int)((a1 & 0xffffu) >> 11) == p;
        const unsigned long long m0 = __ballot(s0), m1 = __ballot(s1);
        const int c0 = __builtin_popcountll(m0);
        const int r0 = n + (int)__builtin_amdgcn_mbcnt_hi((unsigned)(m0 >> 32), __builtin_amdgcn_mbcnt_lo((unsigned)m0, 0u));
        const int r1 = n + c0 + (int)__builtin_amdgcn_mbcnt_hi((unsigned)(m1 >> 32), __builtin_amdgcn_mbcnt_lo((unsigned)m1, 0u));
        if (s0) LP[r0] = (unsigned short)(k * 128 + lane);
        if (s1) LP[r1] = (unsigned short)(k * 128 + 64 + lane);
        n += c0 + __builtin_popcountll(m1);
    }
    if (n == 0) return;
    asm volatile("s_waitcnt lgkmcnt(0)" ::: "memory");
    const int ng = (n + 7) >> 3, pc = lane & 7;
    pg8::u32x4 Ra[8], Rb[8], Xa[8], Xb[8];
    down_rows(Ra, Xa, LP, st0, 0, n, lane, DOWNP);
    int mine = 0;
#pragma unroll 1
    for (int g = 0; g < ng; g += 2) {
        if (g + 1 < ng) down_rows(Rb, Xb, LP, st0, g + 1, n, lane, DOWNP);
        { const int a = down_dot(Ra, Xa); mine = ((g & 7) == pc) ? a : mine; }
        if (g + 1 < ng) {
            if (g + 2 < ng) down_rows(Ra, Xa, LP, st0, g + 2, n, lane, DOWNP);
            const int a = down_dot(Rb, Xb); mine = (((g + 1) & 7) == pc) ? a : mine;
        }
        if ((g & 7) == 6 || g + 2 >= ng) down_finish(mine, LP, st0, LSD, LSU, g & ~7, n, t0, nw, lane, IC);
    }
    asm volatile("s_waitcnt lgkmcnt(0)" ::: "memory");
}
__device__ __forceinline__ void peer_down_phase(Frame& F, const bf16* __restrict__ PROJ, const float* __restrict__ XDQ, const unsigned* __restrict__ IG, unsigned* __restrict__ IC, const unsigned char* __restrict__ DOWN,
                                                const float* __restrict__ SCD, const float* __restrict__ SCU, int p, int w0, int nw) {
    LAS float* LSD = (LAS float*)(F.lds); LAS float* LSU = LSD + 2048;
    LAS unsigned char* wb = F.lds + 16384 + F.wave * DN_WAVE_BYTES;
    LAS unsigned short* LP = (LAS unsigned short*)(wb + DN_BATCH * DN_TOK_BYTES);
    const int lane = F.lane;
    __syncthreads();
    { int t0 = (int)threadIdx.x; asm volatile("" : "+v"(t0));
      for (int i = t0; i < 2048; i += NTHREADS) { LSD[i] = SCD[2048 * p + i]; LSU[i] = SCU[2048 * p + i]; } }
    __syncthreads();
    const unsigned char* DOWNP = DOWN + (size_t)p * 2048 * D;
    const int NT = (M - w0 + nw - 1) / nw;
#pragma unroll 1
    for (int i0 = 0; i0 < NT; i0 += DN_BATCH) {
        const int nb = (NT - i0) < DN_BATCH ? (NT - i0) : DN_BATCH;
        unsigned g0[DN_BATCH], g1[DN_BATCH]; pg8::u32x4 xr[DN_BATCH]; float dqv[DN_BATCH];
#pragma unroll
        for (int k = 0; k < DN_BATCH; ++k) {
            const int t = w0 + (i0 + (k < nb ? k : nb - 1)) * nw;
            g0[k] = __builtin_nontemporal_load(IG + (size_t)t * 128 + lane); g1[k] = __builtin_nontemporal_load(IG + (size_t)t * 128 + 64 + lane);
            xr[k] = __builtin_nontemporal_load((const pg8::u32x4*)((const unsigned char*)(PROJ + (size_t)t * LDP + C_XQ) + 16 * lane));
            dqv[k] = XDQ[t];
        }
#pragma unroll
        for (int k = 0; k < DN_BATCH; ++k) {
            LAS unsigned char* st = wb + k * DN_TOK_BYTES;
            ((LAS unsigned*)st)[lane] = g0[k]; ((LAS unsigned*)st)[64 + lane] = g1[k];
            *(LAS pg8::u32x4*)(st + 512 + 16 * lane) = xr[k];
            if (lane == 0) *(LAS float*)(st + 1536) = dqv[k];
        }
        asm volatile("s_waitcnt vmcnt(0) lgkmcnt(0)" ::: "memory");
#pragma unroll 1
        for (int k = 0; k < nb; k += DN_MERGE) down_process(wb + k * DN_TOK_BYTES, w0 + (i0 + k) * nw, nw, (nb - k) < DN_MERGE ? (nb - k) : DN_MERGE, p, lane, LP, LSD, LSU, DOWNP, IC);
    }
}
__device__ __forceinline__ void up_read_ic(unsigned (&ic)[16], const LAS unsigned char* st, int es) {
#pragma unroll
    for (int q = 0; q < 4; ++q) { const pg8::u32x4 iv = *(const LAS pg8::u32x4*)(st + es * 64 + 16 * q); ic[4 * q] = iv.x; ic[4 * q + 1] = iv.y; ic[4 * q + 2] = iv.z; ic[4 * q + 3] = iv.w; }
}
__device__ __forceinline__ void up_issue_rows(pg8::u32x4 (&R)[16], const unsigned (&ic)[16], const unsigned char* __restrict__ ub) {
#pragma unroll
    for (int i = 0; i < 16; ++i) R[i] = *(const pg8::u32x4*)(ub + ((ic[i] & 0xffffu) << 7));
}
typedef float f32x2 __attribute__((ext_vector_type(2)));
__device__ __forceinline__ void up_compute(const pg8::u32x4 (&R)[16], const unsigned (&ic)[16], const f32x2 x1, f32x2* optr, bool store, int lane) {
    f32x2 acc2[8]; float csum = 0.f;
#pragma unroll
    for (int k = 0; k < 8; ++k) acc2[k] = (f32x2){0.f, 0.f};
#pragma unroll
    for (int i = 0; i < 16; ++i) {
        const float c = __builtin_bit_cast(float, ic[i] & 0xffff0000u); csum += c;
        const f32x2 cc = {c, c};
        const unsigned w4[4] = {R[i].x, R[i].y, R[i].z, R[i].w};
#pragma unroll
        for (int q = 0; q < 4; ++q) {
            const f32x2 lo = {(float)(w4[q] & 0xffu), (float)((w4[q] >> 8) & 0xffu)}, hi = {(float)((w4[q] >> 16) & 0xffu), (float)(w4[q] >> 24)};
            acc2[2 * q] = __builtin_elementwise_fma(cc, lo, acc2[2 * q]); acc2[2 * q + 1] = __builtin_elementwise_fma(cc, hi, acc2[2 * q + 1]);
        }
    }
    float acc[16];
#pragma unroll
    for (int k = 0; k < 8; ++k) { acc[2 * k] = acc2[k].x; acc[2 * k + 1] = acc2[k].y; }
    csum += __shfl_xor(csum, 8); csum += __shfl_xor(csum, 16); csum += __shfl_xor(csum, 32);
#pragma unroll
    for (int k = 0; k < 8; ++k) { const bool up = (lane & 32) != 0; const float send = up ? acc[k] : acc[k + 8], keep = up ? acc[k + 8] : acc[k]; acc[k] = keep + __shfl_xor(send, 32); }
#pragma unroll
    for (int k = 0; k < 4; ++k) { const bool up = (lane & 16) != 0; const float send = up ? acc[k] : acc[k + 4], keep = up ? acc[k + 4] : acc[k]; acc[k] = keep + __shfl_xor(send, 16); }
#pragma unroll
    for (int k = 0; k < 2; ++k) { const bool up = (lane & 8) != 0; const float send = up ? acc[k] : acc[k + 2], keep = up ? acc[k + 2] : acc[k]; acc[k] = keep + __shfl_xor(send, 8); }
    const float off = 128.0f * csum;
    if (store) __builtin_nontemporal_store((f32x2){x1[0] + acc[0] - off, x1[1] + acc[1] - off}, optr);
}
__device__ __forceinline__ void up_compute_reload(pg8::u32x4 (&R)[16], const unsigned (&ic)[16], const unsigned (&icn)[16], const unsigned char* __restrict__ ub, const f32x2 x1, f32x2* optr, int lane) {
    f32x2 acc2[8];
#pragma unroll
    for (int k = 0; k < 8; ++k) acc2[k] = (f32x2){0.f, 0.f};
#pragma unroll
    for (int i = 0; i < 16; ++i) {
        const float c = __builtin_bit_cast(float, ic[i] & 0xffff0000u);
        const f32x2 cc = {c, c};
        const unsigned w4[4] = {R[i].x, R[i].y, R[i].z, R[i].w};
#pragma unroll
        for (int q = 0; q < 4; ++q) {
            const f32x2 lo = __builtin_amdgcn_cvt_pk_f32_fp8((int)w4[q], false), hi = __builtin_amdgcn_cvt_pk_f32_fp8((int)w4[q], true);
            acc2[2 * q] = __builtin_elementwise_fma(cc, lo, acc2[2 * q]); acc2[2 * q + 1] = __builtin_elementwise_fma(cc, hi, acc2[2 * q + 1]);
        }
        __builtin_amdgcn_sched_barrier(0);
        R[i] = *(const pg8::u32x4*)(ub + ((icn[i] & 0xffffu) << 7));
        __builtin_amdgcn_sched_barrier(0);
    }
    float acc[16];
#pragma unroll
    for (int k = 0; k < 8; ++k) { acc[2 * k] = acc2[k].x; acc[2 * k + 1] = acc2[k].y; }
#pragma unroll
    for (int k = 0; k < 8; ++k) { const bool up = (lane & 32) != 0; const float send = up ? acc[k] : acc[k + 8], keep = up ? acc[k + 8] : acc[k]; acc[k] = keep + __shfl_xor(send, 32); }
#pragma unroll
    for (int k = 0; k < 4; ++k) { const bool up = (lane & 16) != 0; const float send = up ? acc[k] : acc[k + 4], keep = up ? acc[k + 4] : acc[k]; acc[k] = keep + __shfl_xor(send, 16); }
#pragma unroll
    for (int k = 0; k < 2; ++k) { const bool up = (lane & 8) != 0; const float send = up ? acc[k] : acc[k + 2], keep = up ? acc[k + 2] : acc[k]; acc[k] = keep + __shfl_xor(send, 8); }
    __builtin_nontemporal_store((f32x2){x1[0] + acc[0], x1[1] + acc[1]}, optr);
}
constexpr int UP_TOK_BYTES = 512 + 512, UP_BATCH = 8, UP_WAVE_BYTES = UP_BATCH * UP_TOK_BYTES;
__device__ __forceinline__ void peer_up_phase(Frame& F, const unsigned* __restrict__ IC, const unsigned char* __restrict__ UP, const bf16* __restrict__ PROJ, float* out, int p, int w0, int nw) {
    const int lane = F.lane, es = lane >> 3, pc = lane & 7;
    const int slot = ((lane >> 5) & 1) * 4 + ((lane >> 4) & 1) * 2 + ((lane >> 3) & 1);
    const unsigned char* ub = UP + (size_t)p * ((size_t)NEXP * 128) + 16 * pc;
    float* ob = out + 128 * p + 16 * pc + 2 * slot;
    const bf16* xb = PROJ + C_X1B + 128 * p + 16 * pc + 2 * slot;
    LAS unsigned char* wb = F.lds + F.wave * (2 * UP_WAVE_BYTES);
    const int NT = (M - w0 + nw - 1) / nw;
    unsigned pg0[2], pg1[2], pxw[2];
#define UP_SLOT(I) (wb + ((I) & 15) * UP_TOK_BYTES)
#define UP_LOAD2(I) do { _Pragma("unroll") for (int q_ = 0; q_ < 2; ++q_) { const int i_ = (I) + q_; const int t_ = w0 + (i_ < NT ? i_ : NT - 1) * nw; \
        pg0[q_] = __builtin_nontemporal_load(IC + (size_t)t_ * 128 + lane); pg1[q_] = __builtin_nontemporal_load(IC + (size_t)t_ * 128 + 64 + lane); \
        pxw[q_] = __builtin_nontemporal_load((const unsigned*)(xb + (size_t)t_ * LDP)); } } while (0)
#define UP_STORE2(I) do { _Pragma("unroll") for (int q_ = 0; q_ < 2; ++q_) { LAS unsigned char* st_ = UP_SLOT((I) + q_); \
        ((LAS unsigned*)st_)[lane] = pg0[q_]; ((LAS unsigned*)st_)[64 + lane] = pg1[q_]; ((LAS unsigned*)(st_ + 512))[lane] = pxw[q_]; } } while (0)
#define UP_X1(I) ({ const unsigned w_ = ((const LAS unsigned*)(UP_SLOT(I) + 512))[lane]; (f32x2){pg8::bf_lo(w_), pg8::bf_hi(w_)}; })
    UP_LOAD2(0); UP_STORE2(0); UP_LOAD2(2); UP_STORE2(2); UP_LOAD2(4); UP_STORE2(4); UP_LOAD2(6);
    asm volatile("s_waitcnt lgkmcnt(0)" ::: "memory");
    unsigned ica[16], icb[16], icn[16]; pg8::u32x4 R0[16], R1[16];
    up_read_ic(ica, UP_SLOT(0), es); up_issue_rows(R0, ica, ub);
    up_read_ic(icb, UP_SLOT(1), es); up_issue_rows(R1, icb, ub);
#pragma unroll 1
    for (int k = 0; k < NT; k += 2) {
        UP_STORE2(k + 6); UP_LOAD2(k + 8);
        up_read_ic(icn, UP_SLOT(k + 2), es);
        up_compute_reload(R0, ica, icn, ub, UP_X1(k), (f32x2*)(ob + (size_t)(w0 + k * nw) * D), lane);
#pragma unroll
        for (int i = 0; i < 16; ++i) ica[i] = icn[i];
        if (k + 1 < NT) {
            up_read_ic(icn, UP_SLOT(k + 3), es);
            up_compute_reload(R1, icb, icn, ub, UP_X1(k + 1), (f32x2*)(ob + (size_t)(w0 + (k + 1) * nw) * D), lane);
#pragma unroll
            for (int i = 0; i < 16; ++i) icb[i] = icn[i];
        }
    }
    asm volatile("s_waitcnt vmcnt(0)" ::: "memory");
    asm volatile("s_waitcnt lgkmcnt(0)" ::: "memory");
#undef UP_SLOT
#undef UP_LOAD2
#undef UP_STORE2
#undef UP_X1
}

constexpr int NPHASE = 9;
#ifndef STAGGER_TICKS
#define STAGGER_TICKS 700
#endif
#ifndef PROBE_REPS
#define PROBE_REPS {1, 1, 1, 1, 1, 1, 1, 1, 1}
#endif
constexpr int probe_rep[NPHASE] = PROBE_REPS;
__global__ void __launch_bounds__(NTHREADS, 2) mega(Args args) {
    extern __shared__ __attribute__((aligned(16))) unsigned char lds[];
    Frame F;
    F.lds = (LAS unsigned char*)lds;
    F.MISC = (volatile LAS unsigned*)(F.lds + MISC_OFF);
    F.tid = threadIdx.x; F.lane = F.tid & 63; F.wave = __builtin_amdgcn_readfirstlane(F.tid >> 6);
    F.G = gridDim.x;
    unsigned char* ws = args.ws;
    F.ctl = (gu32*)(ws + WS_CTL);
    for (int u = F.tid; u < (LDS_BYTES - LDSCTL_OFF) / 4; u += NTHREADS) ((LAS unsigned*)(F.lds + LDSCTL_OFF))[u] = 0u;
    __syncthreads();
    XcdBarrier bar = xcd_barrier_post((unsigned*)(F.ctl + CW_BAR), F.MISC + 8);
    if (F.tid == 0) F.MISC[1] = __hip_atomic_fetch_add(F.ctl + CW_XRANK + 64 * bar.x, 1u, RLX_AGENT);
    const int lo = args.ph_lo, hi = args.ph_hi;
#define IN(k) (lo <= (k) && (k) < hi)
#define BOTH(k) (IN(k) && IN((k) + 1))
    bf16* PROJ = (bf16*)(ws + WS_PROJ);
    bf16* XN = (bf16*)args.out; bf16* T1 = (bf16*)args.out;

    if (IN(0)) for (int rep = 0; rep < probe_rep[0]; ++rep) { p0_prologue(F, args, 0); xcd_barrier(bar); p0_prologue(F, args, 1); if (BOTH(0)) xcd_barrier(bar); }
    if (IN(1)) for (int rep = 0; rep < probe_rep[1]; ++rep) {
        pg8::Gemm g{(const bf16*)args.out, (const bf16*)(ws + WS_W1T), M, NP, D / 2, D / 2, nullptr, 0, D / 2}; pg8::StaticOrder S; S.init(M, NP, F.G, (int)blockIdx.x);
        pg8::EpiProj E{PROJ, (const float*)(ws + WS_SSQ), (const float*)(F.ctl + CW_SWMAX), (unsigned char*)(PROJ + (size_t)M * LDP), F.lds + MISC_OFF + 1024};
        pg8::gemm_phase_i8<pg8::EpiProj, pg8::StaticOrder, true, true>(F.lds + RING_OFF, g, S, E);
        if (BOTH(1)) xcd_barrier(bar);
    }
    if (IN(2)) {
        gu32* qhead = F.ctl + CW_QUEUE;
        for (;;) {
            __syncthreads();
            if (F.tid == 0) F.MISC[0] = __hip_atomic_fetch_add(qhead, 1u, RLX_AGENT);
            __syncthreads();
            const unsigned u = F.MISC[0];
            if (u >= 128u + 1024u) break;
            if (u < 128u) mlstm_unit(F, PROJ, (const float*)(ws + WS_GATES), (const float*)args.in[9], (int)u);
            else attn_unit(F, (bf16*)args.out, PROJ, (const float*)(ws + WS_ROPE), (const float*)args.in[6], (const float*)args.in[7], (const float*)args.in[8], (int)u - 128);
        }
        for (;;) {
            __syncthreads();
            if (F.tid == 0) F.MISC[0] = __hip_atomic_fetch_add(qhead + 64, 1u, RLX_AGENT);
            __syncthreads();
            const unsigned u = F.MISC[0];
            if (u >= (unsigned)TQ_UNITS) break;
            quant_tables_unit(F, args, (int)u);
        }
        if (BOTH(2)) xcd_barrier(bar);
    }
    if (IN(3)) for (int rep = 0; rep < probe_rep[3]; ++rep) {
        pg8::Gemm g{(const bf16*)args.out, (const bf16*)(ws + WS_WAT), M, D, 2 * D, D, PROJ + C_HMN, LDP, D}; pg8::StaticOrder S; S.init(M, D, F.G, (int)blockIdx.x);
        pg8::EpiMixDual E{PROJ + C_MIX, (const unsigned char*)(PROJ + (size_t)M * LDP)};
        pg8::gemm_phase_dual<pg8::EpiMixDual, pg8::StaticOrder, true, true>(F.lds + RING_OFF, g, S, E);
        if (BOTH(3)) xcd_barrier(bar);
    }
    if (IN(5)) for (int rep = 0; rep < probe_rep[5]; ++rep) {
        pg8::Gemm g{PROJ + C_MIX, (const bf16*)(ws + WS_WOT), M, D, D / 2, LDP, nullptr, 0, D / 2}; pg8::StaticOrder S; S.init(M, D, F.G, (int)blockIdx.x);
        pg8::EpiX1 E{(const float*)args.in[0], PROJ + C_X1B, (float*)(ws + WS_SSQ), (const float*)(F.ctl + CW_SWMAX + NP + D)};
        pg8::gemm_phase_i8<pg8::EpiX1, pg8::StaticOrder, true, true>(F.lds + RING_OFF, g, S, E);
        if (BOTH(5)) xcd_barrier(bar);
    }
    if (IN(6)) for (int rep = 0; rep < probe_rep[6]; ++rep) {
        { const int gw = blockIdx.x * NWAVES + F.wave, NGW = F.G * NWAVES;
          QRow qn = quantize_load(PROJ, (const float*)(ws + WS_SSQ), gw < M ? gw : 0, F.lane);
#pragma unroll 1
          for (int t = gw; t < M; t += NGW) { const QRow qc = qn; qn = quantize_load(PROJ, (const float*)(ws + WS_SSQ), (t + NGW < M) ? t + NGW : t, F.lane); quantize_row(qc, PROJ, (float*)(ws + WS_GATES), t, F.lane); } }
        xcd_barrier(bar);
        pg8::Gemm g{PROJ + C_XQ, (const bf16*)(ws + WS_WQT), M, D, D / 2, LDP, nullptr, 0, D / 2}; pg8::StaticOrder S; S.init(M, D, F.G, (int)blockIdx.x);
        pg8::EpiQ E{PROJ + C_QB, (const float*)(ws + WS_GATES), (const float*)(F.ctl + CW_SWMAX + NP)};
        pg8::gemm_phase_i8<pg8::EpiQ, pg8::StaticOrder, true, true>(F.lds + RING_OFF, g, S, E);
        if (BOTH(6)) xcd_barrier(bar);
    }
    if (IN(7)) for (int rep = 0; rep < probe_rep[7]; ++rep) {
        const int gw = blockIdx.x * NWAVES + F.wave, NGW = F.G * NWAVES;
        { const bf16* KEYS = (const bf16*)(ws + WS_KEYS);
#pragma unroll 1
          for (int h = 0; h < 8; ++h) {
              const int ln = (int)__builtin_amdgcn_mbcnt_hi(~0u, __builtin_amdgcn_mbcnt_lo(~0u, 0u));
              __syncthreads();
              for (int i = F.wave * 64 + ln; i < 2 * 128 * 8; i += NTHREADS) { const int row = i >> 3, pc = i & 7; *(LAS v4u*)(F.lds + RT_KEYS_OFF + row * RT_KROW + 16 * pc) = *(const v4u*)(KEYS + (size_t)h * 2 * 128 * 64 + (size_t)row * 64 + 8 * pc); }
              __syncthreads();
#pragma unroll 1
              for (int tt = gw; tt < M / 32; tt += NGW) { RouteQ qc; route_load_q(qc, PROJ, tt, h, ln); route_unit(F, qc, (int*)(ws + WS_IDX), (float*)(ws + WS_GATE), tt, h); }
          } }
        if (BOTH(7)) xcd_barrier(bar);
    }
    if (IN(8)) {
        if (F.tid == 0) {
            int npop = 0, mypos = 0, nloc = 1;
            for (int j = 0; j < 16; ++j) { const unsigned cnt = xb_ld((unsigned*)(F.ctl + CW_BAR) + XB_XCNT(j)); if (cnt) { if (j == (int)bar.x) { mypos = npop; nloc = (int)cnt; } ++npop; } }
            F.MISC[2] = (unsigned)npop; F.MISC[3] = (unsigned)mypos; F.MISC[4] = (unsigned)nloc;
        }
        __syncthreads();
        const int npop = (int)F.MISC[2], mypos = (int)F.MISC[3], nloc = (int)F.MISC[4], rank = (int)F.MISC[1];
        const int w0 = rank * NWAVES + F.wave, nw = nloc * NWAVES;
        for (int p = mypos; p < 8; p += npop)
            peer_down_phase(F, PROJ, (const float*)(ws + WS_GATES), (const unsigned*)(ws + WS_IDX), (unsigned*)(ws + WS_COEF), (const unsigned char*)(ws + WS_DOWN), (const float*)(ws + WS_SCD), (const float*)(ws + WS_SCU), p, w0, nw);
        xcd_barrier(bar);
        for (int p = mypos; p < 8; p += npop)
            peer_up_phase(F, (const unsigned*)(ws + WS_COEF), (const unsigned char*)(ws + WS_UP), PROJ, args.out, p, w0, nw);
    }
#undef IN
#undef BOTH
}

extern "C" void kernel_launch(void* const* d_in, const int* in_sizes, int n_in, void* d_out, int out_size, void* d_ws, size_t ws_size, hipStream_t stream) {
    static int grid = 0;
    if (grid == 0) {
        if (n_in != 18 || out_size != M * D || ws_size < WS_END) { fprintf(stderr, "kernel_launch: unexpected sizes (n_in %d out %d ws %zu)\n", n_in, out_size, ws_size); grid = -1; return; }
        int dev = 0, cus = 0, per_cu = 0;
        (void)hipGetDevice(&dev); (void)hipDeviceGetAttribute(&cus, hipDeviceAttributeMultiprocessorCount, dev);
        (void)hipFuncSetAttribute((const void*)mega, hipFuncAttributeMaxDynamicSharedMemorySize, LDS_BYTES);
        (void)hipOccupancyMaxActiveBlocksPerMultiprocessor(&per_cu, (const void*)mega, NTHREADS, LDS_BYTES);
        if (per_cu < 1) fprintf(stderr, "kernel_launch: occupancy query says %d\n", per_cu);
        (void)hipGetLastError();
        grid = cus;
    }
    if (grid < 0) return;
    unsigned char* ws = (unsigned char*)d_ws;
    float* out = (float*)d_out;
    bf16* PROJ = (bf16*)(ws + WS_PROJ);
    (void)hipMemsetAsync(ws + WS_CTL, 0, CTL_ZERO_BYTES, stream);
    Args a{};
    for (int i = 0; i < 18; ++i) a.in[i] = d_in[i];
    a.out = out; a.ws = ws;
    a.ph_lo = 0; a.ph_hi = 9;
    hipLaunchKernelGGL(mega, dim3(grid), dim3(NTHREADS), LDS_BYTES, stream, a);
}
```

```cpp
#include <hip/hip_runtime.h>
#include <cstdio>
#include <cstdint>
namespace pg8 {
#define PG8_LAS __attribute__((address_space(3)))
typedef unsigned short bf16_t;
typedef short bf16x8 __attribute__((ext_vector_type(8)));
typedef float f32x4 __attribute__((ext_vector_type(4)));
typedef unsigned u32x4 __attribute__((ext_vector_type(4)));
typedef int i32x4 __attribute__((ext_vector_type(4)));
constexpr int BM = 256, BK = 64, HALF = 128, HTB = HALF * BK * 2  , STAGE_BYTES = 8 * HTB, NXCD = 8, WGM = 8;

__host__ __device__ __forceinline__ int lds_byte(int r, int c) { const int st = (r >> 4) * 2 + (c >> 5), rr = r & 15, cc = c & 31, ob = rr * 64 + cc * 2; return st * 1024 + (ob ^ (((ob >> 9) & 1) << 5)); }
__host__ __device__ __forceinline__ void stage_rc(int b, int& R, int& C) { const int st = b / 1024, sb = b % 1024, swz = sb ^ (((sb >> 9) & 1) << 5); R = (st >> 1) * 16 + swz / 64; C = (st & 1) * 32 + (swz % 64) / 2; }
__host__ __device__ __forceinline__ int perm32(int rho) { const int n = rho >> 4, i = rho & 15; return 8 * (i >> 2) + 4 * n + (i & 3); }

struct Unit { int pm, pn; };
struct Gemm { const bf16_t* A; const bf16_t* Bt; int M, N, K, lda; const bf16_t* A2; int lda2, K1; };

struct StaticOrder {
    int nM, nN, nwg, G, c;
    __host__ __device__ void init(int M, int N, int G_, int c_) { nM = M / BM; nN = N / BM; nwg = nM * nN; G = G_; c = c_; }
    __host__ __device__ bool next(int i, Unit& u) const {
        const long L = (long)i * G + c; if (L >= nwg) return false;
        int wgid = (int)L; { const int q = nwg / NXCD, r = nwg % NXCD, xcd = wgid % NXCD, off = wgid / NXCD; wgid = (xcd < r ? xcd * (q + 1) : r * (q + 1) + (xcd - r) * q) + off; }
        const int nig = WGM * nN, gid = wgid / nig, fm = gid * WGM, gsz = (nM - fm) < WGM ? (nM - fm) : WGM;
        u.pm = fm + ((wgid % nig) % gsz); u.pn = (wgid % nig) / gsz; return true;
    }
    __device__ __forceinline__ void a_ready(const Unit&) const {}
    __device__ __forceinline__ void done(const Unit&) const {}
};

__device__ __forceinline__ unsigned cvt_pk_bf16(float lo, float hi) { unsigned r; asm volatile("v_cvt_pk_bf16_f32 %0, %1, %2" : "=v"(r) : "v"(lo), "v"(hi)); return r; }
__device__ __forceinline__ float bf_lo(unsigned w) { return __builtin_bit_cast(float, w << 16); }
__device__ __forceinline__ float bf_hi(unsigned w) { return __builtin_bit_cast(float, w & 0xffff0000u); }
__device__ __forceinline__ float fast_sigmoid(float x) { return __builtin_amdgcn_rcpf(1.0f + __expf(-x)); }
__device__ __forceinline__ void unpack8(const u32x4 w, float (&f)[8]) { f[0] = bf_lo(w.x); f[1] = bf_hi(w.x); f[2] = bf_lo(w.y); f[3] = bf_hi(w.y); f[4] = bf_lo(w.z); f[5] = bf_hi(w.z); f[6] = bf_lo(w.w); f[7] = bf_hi(w.w); }
__device__ __forceinline__ u32x4 pack8(const float (&f)[8]) { u32x4 w; w.x = cvt_pk_bf16(f[0], f[1]); w.y = cvt_pk_bf16(f[2], f[3]); w.z = cvt_pk_bf16(f[4], f[5]); w.w = cvt_pk_bf16(f[6], f[7]); return w; }
constexpr int LDP = 4352;
constexpr int GPM = 65536;
constexpr float MIX_CLIP = 3.2f, MIX_ISCALE = 127.0f / MIX_CLIP;

struct EpiProj {
    static constexpr bool PERM = true, AFTER_DRAIN = false, HAS_PRE = true;
    bf16_t* O; const float* SX; const float* SW;
    unsigned char* GP;
    PG8_LAS unsigned char* L;
    struct Pre {};
    __device__ __forceinline__ void preload(Pre&, const Unit& u, int wid, int lane) const {
        const float* src = (wid < 4) ? SW + u.pn * BM + wid * 64 + lane : SX + u.pm * BM + (wid - 4) * 64 + lane;
        __builtin_amdgcn_global_load_lds((const unsigned*)src, (PG8_LAS unsigned*)(L + wid * 256), 4, 0, 0);
    }
    __device__ __forceinline__ void operator()(const i32x4 (&acc)[2][2][4][2], const Unit& u, int wr, int wc, int fr, int fq, const Pre&) const {
        const int row0 = u.pm * BM + wr * 64 + fr, col0 = u.pn * BM + wc * 32 + 8 * fq;
        const float sc = (u.pn == 7 || u.pn == 8) ? 0.125f : 1.f; const bool sig = u.pn >= 13, gates = u.pn >= 17;
        unsigned char* gbase = GP + (size_t)(u.pn - 17) * ((size_t)GPM * 256) + 16 * (4 * wc + fq);
        float sw[2][8]; f32x4 lw[2][2];
#pragma unroll
        for (int bj = 0; bj < 2; ++bj) { lw[bj][0] = *(const PG8_LAS f32x4*)(L + (wc * 32 + 8 * fq + bj * HALF) * 4); lw[bj][1] = *(const PG8_LAS f32x4*)(L + (wc * 32 + 8 * fq + bj * HALF) * 4 + 16); }
#pragma unroll
        for (int bj = 0; bj < 2; ++bj)
#pragma unroll
            for (int e = 0; e < 4; ++e) { sw[bj][e] = lw[bj][0][e] * (sc * (1.0f / 127.0f)); sw[bj][4 + e] = lw[bj][1][e] * (sc * (1.0f / 127.0f)); }
#pragma unroll
        for (int ai = 0; ai < 2; ++ai) {
#pragma unroll
            for (int m = 0; m < 4; ++m) { bf16_t* rowp = O + (size_t)(row0 + ai * HALF + m * 16) * LDP + col0; const float sxm = *(const PG8_LAS float*)(L + 1024 + (wr * 64 + fr + ai * HALF + m * 16) * 4);
                float f[2][8];
#pragma unroll
                for (int bj = 0; bj < 2; ++bj)
#pragma unroll
                    for (int e = 0; e < 4; ++e) { f[bj][e] = (float)acc[ai][bj][m][0][e] * (sxm * sw[bj][e]); f[bj][4 + e] = (float)acc[ai][bj][m][1][e] * (sxm * sw[bj][4 + e]); }
                if (sig) {
#pragma unroll
                    for (int e = 0; e < 8; ++e) {
                        const float ea = __expf(-f[0][e]), eb = __expf(-f[1][e]);
                        f[0][e] = __builtin_amdgcn_rcpf(1.0f + ea); f[1][e] = __builtin_amdgcn_rcpf(1.0f + eb); }
                }
                if (gates) {
                    unsigned g4[4] = {0u, 0u, 0u, 0u};
#pragma unroll
                    for (int e = 0; e < 4; ++e) { g4[0] = __builtin_amdgcn_cvt_pk_u8_f32(f[0][e] * 255.0f, e, g4[0]); g4[1] = __builtin_amdgcn_cvt_pk_u8_f32(f[0][4 + e] * 255.0f, e, g4[1]);
                                                  g4[2] = __builtin_amdgcn_cvt_pk_u8_f32(f[1][e] * 255.0f, e, g4[2]); g4[3] = __builtin_amdgcn_cvt_pk_u8_f32(f[1][4 + e] * 255.0f, e, g4[3]); }
                    *(u32x4*)(gbase + (size_t)(row0 + ai * HALF + m * 16) * 256) = (u32x4){g4[0], g4[1], g4[2], g4[3]};
                } else if (sig) {
                    unsigned g4[4] = {0u, 0u, 0u, 0u};
#pragma unroll
                    for (int e = 0; e < 4; ++e) { g4[0] = __builtin_amdgcn_cvt_pk_u8_f32(f[0][e] * 255.0f, e, g4[0]); g4[1] = __builtin_amdgcn_cvt_pk_u8_f32(f[0][4 + e] * 255.0f, e, g4[1]);
                                                  g4[2] = __builtin_amdgcn_cvt_pk_u8_f32(f[1][e] * 255.0f, e, g4[2]); g4[3] = __builtin_amdgcn_cvt_pk_u8_f32(f[1][4 + e] * 255.0f, e, g4[3]); }
                    typedef unsigned u32x2w __attribute__((ext_vector_type(2)));
                    unsigned char* mp = (unsigned char*)(O + (size_t)(row0 + ai * HALF + m * 16) * LDP + 3328) + (col0 - 3328);
                    *(u32x2w*)(mp) = (u32x2w){g4[0], g4[1]}; *(u32x2w*)(mp + HALF) = (u32x2w){g4[2], g4[3]};
                } else { *(u32x4*)(rowp) = pack8(f[0]); *(u32x4*)(rowp + HALF) = pack8(f[1]); } }
        }
    }
};
struct EpiX1 {
    static constexpr bool PERM = true, AFTER_DRAIN = false, HAS_PRE = false; struct Pre {};
    const float* X; bf16_t* X1B; float* SSQ; const float* SW;
    __device__ __forceinline__ void operator()(const i32x4 (&acc)[2][2][4][2], const Unit& u, int wr, int wc, int fr, int fq) const {
        const int row0 = u.pm * BM + wr * 64 + fr, col0 = u.pn * BM + wc * 32 + 8 * fq;
        f32x4 sw[2][2];
#pragma unroll
        for (int bj = 0; bj < 2; ++bj)
#pragma unroll
            for (int n = 0; n < 2; ++n) sw[bj][n] = *(const f32x4*)(SW + col0 + bj * HALF + 4 * n) * (MIX_CLIP / (127.0f * 127.0f));
#pragma unroll
        for (int ai = 0; ai < 2; ++ai)
#pragma unroll
          for (int mh = 0; mh < 2; ++mh) {
            f32x4 xv[2][2][2];
#pragma unroll
            for (int m2 = 0; m2 < 2; ++m2)
#pragma unroll
                for (int bj = 0; bj < 2; ++bj) { const size_t off = (size_t)(row0 + ai * HALF + (2 * mh + m2) * 16) * 1024 + col0 + bj * HALF; xv[m2][bj][0] = *(const f32x4*)(X + off); xv[m2][bj][1] = *(const f32x4*)(X + off + 4); }
#pragma unroll
            for (int m2 = 0; m2 < 2; ++m2) { const int m = 2 * mh + m2; const size_t row = (size_t)(row0 + ai * HALF + m * 16); float ss = 0.f;
#pragma unroll
                for (int bj = 0; bj < 2; ++bj) { const size_t off = row * 1024 + col0 + bj * HALF;
                    f32x4 a, b;
#pragma unroll
                    for (int e = 0; e < 4; ++e) { a[e] = xv[m2][bj][0][e] + (float)acc[ai][bj][m][0][e] * sw[bj][0][e]; b[e] = xv[m2][bj][1][e] + (float)acc[ai][bj][m][1][e] * sw[bj][1][e]; }
                    { const float ab[8] = {a[0], a[1], a[2], a[3], b[0], b[1], b[2], b[3]}; *(u32x4*)(X1B + row * LDP + col0 + bj * HALF) = pack8(ab); }
                    ss += (a[0] * a[0] + a[1] * a[1]) + (a[2] * a[2] + a[3] * a[3]) + (b[0] * b[0] + b[1] * b[1]) + (b[2] * b[2] + b[3] * b[3]); }
                ss += __shfl_xor(ss, 16); ss += __shfl_xor(ss, 32);
                if (fq == 0) SSQ[row * 16 + u.pn * 4 + wc] = ss; }
          }
    }
};
struct EpiQ {
    static constexpr bool PERM = true, AFTER_DRAIN = false, HAS_PRE = false; struct Pre {};
    bf16_t* O; const float* XDQ; const float* SW;
    __device__ __forceinline__ void operator()(const i32x4 (&acc)[2][2][4][2], const Unit& u, int wr, int wc, int fr, int fq) const {
        const int row0 = u.pm * BM + wr * 64 + fr, col0 = u.pn * BM + wc * 32 + 8 * fq;
        float sw[2][8];
#pragma unroll
        for (int bj = 0; bj < 2; ++bj) { const f32x4 w0 = *(const f32x4*)(SW + col0 + bj * HALF), w1 = *(const f32x4*)(SW + col0 + bj * HALF + 4);
#pragma unroll
            for (int e = 0; e < 4; ++e) { sw[bj][e] = w0[e] * (1.0f / 127.0f); sw[bj][4 + e] = w1[e] * (1.0f / 127.0f); } }
#pragma unroll
        for (int ai = 0; ai < 2; ++ai) {
            float sx[4];
#pragma unroll
            for (int m = 0; m < 4; ++m) sx[m] = XDQ[row0 + ai * HALF + m * 16];
#pragma unroll
            for (int m = 0; m < 4; ++m) { const size_t row = (size_t)(row0 + ai * HALF + m * 16);
#pragma unroll
                for (int bj = 0; bj < 2; ++bj) { float f[8];
#pragma unroll
                    for (int e = 0; e < 4; ++e) { f[e] = (float)acc[ai][bj][m][0][e] * (sx[m] * sw[bj][e]); f[4 + e] = (float)acc[ai][bj][m][1][e] * (sx[m] * sw[bj][4 + e]); }
                    *(u32x4*)(O + row * LDP + col0 + bj * HALF) = pack8(f); } }
        }
    }
};
struct EpiMixDual {
    static constexpr bool PERM = true, AFTER_DRAIN = false;
    bf16_t* O; const unsigned char* G;
    __device__ __forceinline__ void mid(f32x4 (&acc)[2][2][4][2], const Unit& u, int wr, int wc, int fr, int fq) const {
        const int row0 = u.pm * BM + wr * 64 + fr;
        const unsigned char* g0 = G + ((size_t)(2 * u.pn) * GPM + (size_t)row0) * 256 + 16 * (4 * wc + fq);
#pragma unroll
        for (int bj = 0; bj < 2; ++bj) {
            u32x4 rv[2][4];
#pragma unroll
            for (int ai = 0; ai < 2; ++ai)
#pragma unroll
                for (int m = 0; m < 4; ++m) rv[ai][m] = *(const u32x4*)(g0 + (size_t)bj * ((size_t)GPM * 256) + (ai * HALF + m * 16) * 256);
#pragma unroll
            for (int ai = 0; ai < 2; ++ai)
#pragma unroll
                for (int m = 0; m < 4; ++m) {
                    const unsigned ga[2] = {rv[ai][m].x, rv[ai][m].y}, gm[2] = {rv[ai][m].z, rv[ai][m].w};
#pragma unroll
                    for (int n = 0; n < 2; ++n)
#pragma unroll
                        for (int e = 0; e < 4; ++e) acc[ai][bj][m][n][e] *= (float)((ga[n] >> (8 * e)) & 0xffu) * __builtin_amdgcn_rcpf(fmaxf((float)((gm[n] >> (8 * e)) & 0xffu), 1.0f));
                }
            asm volatile("" ::: "memory");
        }
    }
    __device__ __forceinline__ void operator()(const f32x4 (&acc)[2][2][4][2], const Unit& u, int wr, int wc, int fr, int fq) const {
        const int row0 = u.pm * BM + wr * 64 + fr, col0 = u.pn * BM + wc * 32 + 8 * fq;
        typedef unsigned u32x2v __attribute__((ext_vector_type(2)));
        const unsigned char* g0 = G + ((size_t)(2 * u.pn) * GPM + (size_t)row0) * 256 + 16 * (4 * wc + fq) + 8;
#pragma unroll
        for (int ai = 0; ai < 2; ++ai) {
            u32x2v gv[4][2];
#pragma unroll
            for (int m = 0; m < 4; ++m)
#pragma unroll
                for (int bj = 0; bj < 2; ++bj) gv[m][bj] = *(const u32x2v*)(g0 + (size_t)bj * ((size_t)GPM * 256) + (ai * HALF + m * 16) * 256);
#pragma unroll
            for (int m = 0; m < 4; ++m) { const size_t row = (size_t)(row0 + ai * HALF + m * 16);
#pragma unroll
                for (int bj = 0; bj < 2; ++bj) { unsigned w2[2];
#pragma unroll
                    for (int n = 0; n < 2; ++n) { unsigned a4 = 0u;
#pragma unroll
                        for (int e = 0; e < 4; ++e) { float v = acc[ai][bj][m][n][e] * fmaxf((float)((gv[m][bj][n] >> (8 * e)) & 0xffu), 1.0f) * (MIX_ISCALE / 255.0f); v = fminf(fmaxf(v, -127.f), 127.f); a4 |= (unsigned)((int)__builtin_rintf(v) & 0xff) << (8 * e); }
                        w2[n] = a4; }
                    *(u32x2v*)((unsigned char*)(O + row * LDP) + col0 + bj * HALF) = (u32x2v){w2[0], w2[1]}; } }
        }
    }
};
template <class Epi, class Sched, bool ALIGN_EPI = false, bool SP2 = false>
__device__ __forceinline__ void gemm_phase(PG8_LAS unsigned char* lds, const Gemm g, const Sched& S, const Epi& E) {
    const int tid = threadIdx.x, wid = __builtin_amdgcn_readfirstlane(tid >> 6), lane = tid & 63, wr = wid >> 2, wc = wid & 3, fr = lane & 15, fq = lane >> 4;
    const int K = g.K, nt = K / BK;
    unsigned voffA[2], voffB[2];
#pragma unroll
    for (int i = 0; i < 2; ++i) { int R, C; stage_rc(tid * 16 + i * 8192, R, C); const int Rb = Epi::PERM ? ((R & ~31) + perm32(R & 31)) : R;
        voffA[i] = (unsigned)(R * g.lda + C) * 2u; voffB[i] = (unsigned)(Rb * K + C) * 2u; }
    const size_t kstep = (size_t)(BK * 2);
    const size_t hstepB = (size_t)HALF * K * 2, hstepA = (size_t)HALF * g.lda * 2;
    const size_t tstepA = 2 * hstepA, tstepB = 2 * hstepB;
    const unsigned ldsw = (unsigned)wid * 1024u;
    const int aoff = lds_byte(wr * 64 + fr, fq * 8), boff = lds_byte(wc * 32 + fr, fq * 8);
#define PG8_SA(b, h) (((b) * 2 + (h)) * HTB)
#define PG8_SB(b, h) ((4 + (b) * 2 + (h)) * HTB)
#define PG8_STAGE(bufoff, gbase, voff) do { _Pragma("unroll") for (int _i = 0; _i < 2; ++_i) \
        __builtin_amdgcn_global_load_lds((const unsigned*)((const char*)(gbase) + (voff)[_i]), (PG8_LAS unsigned*)(lds + (bufoff) + ldsw + _i * 8192), 16, 0, 0); } while (0)
#define PG8_LDA(dst, b, h) do { _Pragma("unroll") for (int m = 0; m < 4; ++m) _Pragma("unroll") for (int k = 0; k < 2; ++k) dst[m][k] = *(const PG8_LAS bf16x8*)(lds + PG8_SA(b, h) + aoff + m * 2048 + k * 1024); } while (0)
#define PG8_LDB(dst, b, h) do { _Pragma("unroll") for (int n = 0; n < 2; ++n) _Pragma("unroll") for (int k = 0; k < 2; ++k) dst[n][k] = *(const PG8_LAS bf16x8*)(lds + PG8_SB(b, h) + boff + n * 2048 + k * 1024); } while (0)
#define PG8_MMA(ai, bj, At, Bt) do { __builtin_amdgcn_s_setprio(1); _Pragma("unroll") for (int m = 0; m < 4; ++m) _Pragma("unroll") for (int n = 0; n < 2; ++n) _Pragma("unroll") for (int k = 0; k < 2; ++k) \
        acc[ai][bj][m][n] = __builtin_amdgcn_mfma_f32_16x16x32_bf16(Bt[n][k], At[m][k], acc[ai][bj][m][n], 0, 0, 0); __builtin_amdgcn_s_setprio(0); } while (0)
#define PG8_WAIT_V(n) asm volatile("s_waitcnt vmcnt(" #n ")" ::: "memory")
#define PG8_WAIT_L(n) asm volatile("s_waitcnt lgkmcnt(" #n ")" ::: "memory")
#define PG8_BAR __builtin_amdgcn_s_barrier()
#define PG8_SCHED __builtin_amdgcn_sched_barrier(0)
    Unit cur, nxt; int ui = 0;
    if (!S.next(0, cur)) return;
    f32x4 acc[2][2][4][2];
#pragma unroll
    for (int a = 0; a < 2; ++a)
#pragma unroll
        for (int b = 0; b < 2; ++b)
#pragma unroll
            for (int m = 0; m < 4; ++m)
#pragma unroll
                for (int n = 0; n < 2; ++n) acc[a][b][m][n] = (f32x4){0.f, 0.f, 0.f, 0.f};
    bf16x8 At[4][2], B0[2][2], B1[2][2];
    const char* cA = (const char*)g.A + (size_t)cur.pm * tstepA; const char* cB = (const char*)g.Bt + (size_t)cur.pn * tstepB;
    S.a_ready(cur);
    if constexpr (SP2) {
        PG8_STAGE(PG8_SB(0, 0), cB, voffB); PG8_STAGE(PG8_SB(0, 1), cB + hstepB, voffB); PG8_STAGE(PG8_SA(0, 0), cA, voffA); PG8_STAGE(PG8_SA(0, 1), cA + hstepA, voffA);
        if (wr == 1) PG8_BAR;
        PG8_WAIT_V(2); PG8_BAR;
        PG8_STAGE(PG8_SB(1, 0), cB + kstep, voffB); PG8_STAGE(PG8_SA(1, 0), cA + kstep, voffA); PG8_STAGE(PG8_SB(1, 1), cB + hstepB + kstep, voffB);
        PG8_WAIT_V(6); PG8_BAR;
    } else {
        PG8_STAGE(PG8_SB(0, 0), cB, voffB); PG8_STAGE(PG8_SA(0, 0), cA, voffA); PG8_STAGE(PG8_SB(0, 1), cB + hstepB, voffB); PG8_STAGE(PG8_SA(0, 1), cA + hstepA, voffA);
        if (wr == 1) PG8_BAR;
        PG8_WAIT_V(4); PG8_BAR;
        PG8_STAGE(PG8_SB(1, 0), cB + kstep, voffB); PG8_STAGE(PG8_SA(1, 0), cA + kstep, voffA); PG8_STAGE(PG8_SB(1, 1), cB + hstepB + kstep, voffB);
        PG8_WAIT_V(6); PG8_BAR;
    }
    for (;;) {
        const bool has_next = S.next(ui + 1, nxt);
        const char* nA = has_next ? (const char*)g.A + (size_t)nxt.pm * tstepA : cA; const char* nB = has_next ? (const char*)g.Bt + (size_t)nxt.pn * tstepB : cB;
        for (int t = 0; t < nt; t += 2) {
            const bool last = (t == nt - 2);
            const char* a1 = cA + (size_t)(t + 1) * kstep;
            const char* a2 = last ? nA : cA + (size_t)(t + 2) * kstep; const char* b2 = last ? nB : cB + (size_t)(t + 2) * kstep;
            const char* a3 = a2 + kstep; const char* b3 = b2 + kstep;
            if (last && has_next) S.a_ready(nxt);
            if constexpr (SP2) {
            PG8_LDB(B0, 0, 0); PG8_LDB(B1, 0, 1); PG8_SCHED; PG8_LDA(At, 0, 0); PG8_STAGE(PG8_SA(1, 1), a1 + hstepA, voffA);
            PG8_WAIT_V(8); PG8_WAIT_L(0); PG8_BAR; PG8_MMA(0, 0, At, B0); PG8_MMA(0, 1, At, B1); PG8_BAR; PG8_SCHED;
            PG8_LDA(At, 0, 1); PG8_STAGE(PG8_SB(0, 0), b2, voffB); PG8_STAGE(PG8_SB(0, 1), b2 + hstepB, voffB); PG8_STAGE(PG8_SA(0, 0), a2, voffA);
            PG8_WAIT_V(8); PG8_WAIT_L(0); PG8_BAR; PG8_MMA(1, 0, At, B0); PG8_MMA(1, 1, At, B1); PG8_BAR; PG8_SCHED;
            PG8_LDB(B0, 1, 0); PG8_LDB(B1, 1, 1); PG8_SCHED; PG8_LDA(At, 1, 0); PG8_STAGE(PG8_SA(0, 1), a2 + hstepA, voffA);
            PG8_WAIT_V(8); PG8_WAIT_L(0); PG8_BAR; PG8_MMA(0, 0, At, B0); PG8_MMA(0, 1, At, B1); PG8_BAR; PG8_SCHED;
            PG8_LDA(At, 1, 1); PG8_STAGE(PG8_SB(1, 0), b3, voffB); PG8_STAGE(PG8_SB(1, 1), b3 + hstepB, voffB); PG8_STAGE(PG8_SA(1, 0), a3, voffA);
            PG8_WAIT_V(8); PG8_WAIT_L(0); PG8_BAR; PG8_MMA(1, 0, At, B0); PG8_MMA(1, 1, At, B1); PG8_BAR; PG8_SCHED;
            } else {
            PG8_LDB(B0, 0, 0); PG8_SCHED; PG8_LDA(At, 0, 0); PG8_STAGE(PG8_SA(1, 1), a1 + hstepA, voffA);
            PG8_WAIT_L(8); PG8_BAR; PG8_WAIT_L(0); PG8_MMA(0, 0, At, B0); PG8_BAR; PG8_SCHED;
            PG8_LDB(B1, 0, 1); PG8_STAGE(PG8_SB(0, 0), b2, voffB);
            PG8_BAR; PG8_WAIT_L(0); PG8_MMA(0, 1, At, B1); PG8_BAR;
            PG8_LDA(At, 0, 1); PG8_STAGE(PG8_SA(0, 0), a2, voffA);
            PG8_BAR; PG8_WAIT_L(0); PG8_MMA(1, 0, At, B0); PG8_BAR; PG8_SCHED;
            PG8_STAGE(PG8_SB(0, 1), b2 + hstepB, voffB);
            PG8_WAIT_V(6); PG8_BAR; PG8_MMA(1, 1, At, B1); PG8_BAR;
            PG8_LDB(B0, 1, 0); PG8_SCHED; PG8_LDA(At, 1, 0); PG8_STAGE(PG8_SA(0, 1), a2 + hstepA, voffA);
            PG8_WAIT_L(8); PG8_BAR; PG8_WAIT_L(0); PG8_MMA(0, 0, At, B0); PG8_BAR; PG8_SCHED;
            PG8_LDB(B1, 1, 1); PG8_STAGE(PG8_SB(1, 0), b3, voffB);
            PG8_BAR; PG8_WAIT_L(0); PG8_MMA(0, 1, At, B1); PG8_BAR;
            PG8_LDA(At, 1, 1); PG8_STAGE(PG8_SA(1, 0), a3, voffA);
            PG8_BAR; PG8_WAIT_L(0); PG8_MMA(1, 0, At, B0); PG8_BAR; PG8_SCHED;
            PG8_STAGE(PG8_SB(1, 1), b3 + hstepB, voffB);
            PG8_WAIT_V(6); PG8_BAR; PG8_MMA(1, 1, At, B1); PG8_BAR;
            }
        }
        if constexpr (ALIGN_EPI) { if (wr == 0) PG8_BAR; }
        if constexpr (!Epi::AFTER_DRAIN) { E(acc, cur, wr, wc, fr, fq); S.done(cur); }
        if (!has_next) break;
#pragma unroll
        for (int a = 0; a < 2; ++a)
#pragma unroll
            for (int b = 0; b < 2; ++b)
#pragma unroll
                for (int m = 0; m < 4; ++m)
#pragma unroll
                    for (int n = 0; n < 2; ++n) acc[a][b][m][n] = (f32x4){0.f, 0.f, 0.f, 0.f};
        cur = nxt; cA = nA; cB = nB; ++ui;
        if constexpr (ALIGN_EPI) { if (wr == 1) PG8_BAR; }
    }
    PG8_WAIT_V(0);
    if constexpr (!ALIGN_EPI) { if (wr == 0) PG8_BAR; }
    PG8_BAR;
    if constexpr (Epi::AFTER_DRAIN) { E.fused(acc, cur, wr, wc, fr, fq, lds, wid, lane); S.done(cur); }
#undef PG8_SA
#undef PG8_SB
#undef PG8_STAGE
#undef PG8_LDA
#undef PG8_LDB
#undef PG8_MMA
#undef PG8_WAIT_V
#undef PG8_WAIT_L
#undef PG8_BAR
#undef PG8_SCHED
}
template <class Epi, class Sched, bool ALIGN_EPI = false, bool SP2 = false>
__device__ __forceinline__ void gemm_phase_i8(PG8_LAS unsigned char* lds, const Gemm g, const Sched& S, const Epi& E) {
    const int tid = threadIdx.x, wid = __builtin_amdgcn_readfirstlane(tid >> 6), lane = tid & 63, wr = wid >> 2, wc = wid & 3, fr = lane & 15, fq = lane >> 4;
    const int K = g.K, nt = K / BK;
    unsigned voffA[2], voffB[2];
#pragma unroll
    for (int i = 0; i < 2; ++i) { int R, C; stage_rc(tid * 16 + i * 8192, R, C); const int Rb = Epi::PERM ? ((R & ~31) + perm32(R & 31)) : R;
        voffA[i] = (unsigned)(R * g.lda + C) * 2u; voffB[i] = (unsigned)(Rb * K + C) * 2u; }
    const size_t kstep = (size_t)(BK * 2);
    const size_t hstepB = (size_t)HALF * K * 2, hstepA = (size_t)HALF * g.lda * 2;
    const size_t tstepA = 2 * hstepA, tstepB = 2 * hstepB;
    const unsigned ldsw = (unsigned)wid * 1024u;
    const int aoff = lds_byte(wr * 64 + fr, fq * 8), boff = lds_byte(wc * 32 + fr, fq * 8);
#define PG8_SA(b, h) (((b) * 2 + (h)) * HTB)
#define PG8_SB(b, h) ((4 + (b) * 2 + (h)) * HTB)
#define PG8_STAGE(bufoff, gbase, voff) do { _Pragma("unroll") for (int _i = 0; _i < 2; ++_i) \
        __builtin_amdgcn_global_load_lds((const unsigned*)((const char*)(gbase) + (voff)[_i]), (PG8_LAS unsigned*)(lds + (bufoff) + ldsw + _i * 8192), 16, 0, 0); } while (0)
#define PG8_LDA(dst, b, h) do { _Pragma("unroll") for (int m = 0; m < 4; ++m) _Pragma("unroll") for (int k = 0; k < 2; ++k) dst[m][k] = *(const PG8_LAS bf16x8*)(lds + PG8_SA(b, h) + aoff + m * 2048 + k * 1024); } while (0)
#define PG8_LDB(dst, b, h) do { _Pragma("unroll") for (int n = 0; n < 2; ++n) _Pragma("unroll") for (int k = 0; k < 2; ++k) dst[n][k] = *(const PG8_LAS bf16x8*)(lds + PG8_SB(b, h) + boff + n * 2048 + k * 1024); } while (0)
#define PG8_MMA(ai, bj, At, Bt) do { __builtin_amdgcn_s_setprio(1); _Pragma("unroll") for (int m = 0; m < 4; ++m) _Pragma("unroll") for (int n = 0; n < 2; ++n) _Pragma("unroll") for (int k = 0; k < 2; ++k) \
        acc[ai][bj][m][n] = __builtin_amdgcn_mfma_i32_16x16x64_i8(__builtin_bit_cast(i32x4, Bt[n][k]), __builtin_bit_cast(i32x4, At[m][k]), acc[ai][bj][m][n], 0, 0, 0); __builtin_amdgcn_s_setprio(0); } while (0)
#define PG8_WAIT_V(n) asm volatile("s_waitcnt vmcnt(" #n ")" ::: "memory")
#define PG8_WAIT_L(n) asm volatile("s_waitcnt lgkmcnt(" #n ")" ::: "memory")
#define PG8_BAR __builtin_amdgcn_s_barrier()
#define PG8_SCHED __builtin_amdgcn_sched_barrier(0)
    Unit cur, nxt; int ui = 0;
    if (!S.next(0, cur)) return;
    i32x4 acc[2][2][4][2];
#pragma unroll
    for (int a = 0; a < 2; ++a)
#pragma unroll
        for (int b = 0; b < 2; ++b)
#pragma unroll
            for (int m = 0; m < 4; ++m)
#pragma unroll
                for (int n = 0; n < 2; ++n) acc[a][b][m][n] = (i32x4){0, 0, 0, 0};
    bf16x8 At[4][2], B0[2][2], B1[2][2];
    typename Epi::Pre pre;
    const char* cA = (const char*)g.A + (size_t)cur.pm * tstepA; const char* cB = (const char*)g.Bt + (size_t)cur.pn * tstepB;
    S.a_ready(cur);
    if constexpr (SP2) {
        PG8_STAGE(PG8_SB(0, 0), cB, voffB); PG8_STAGE(PG8_SB(0, 1), cB + hstepB, voffB); PG8_STAGE(PG8_SA(0, 0), cA, voffA); PG8_STAGE(PG8_SA(0, 1), cA + hstepA, voffA);
        if (wr == 1) PG8_BAR;
        PG8_WAIT_V(2); PG8_BAR;
        PG8_STAGE(PG8_SB(1, 0), cB + kstep, voffB); PG8_STAGE(PG8_SA(1, 0), cA + kstep, voffA); PG8_STAGE(PG8_SB(1, 1), cB + hstepB + kstep, voffB);
        PG8_WAIT_V(6); PG8_BAR;
    } else {
        PG8_STAGE(PG8_SB(0, 0), cB, voffB); PG8_STAGE(PG8_SA(0, 0), cA, voffA); PG8_STAGE(PG8_SB(0, 1), cB + hstepB, voffB); PG8_STAGE(PG8_SA(0, 1), cA + hstepA, voffA);
        if (wr == 1) PG8_BAR;
        PG8_WAIT_V(4); PG8_BAR;
        PG8_STAGE(PG8_SB(1, 0), cB + kstep, voffB); PG8_STAGE(PG8_SA(1, 0), cA + kstep, voffA); PG8_STAGE(PG8_SB(1, 1), cB + hstepB + kstep, voffB);
        PG8_WAIT_V(6); PG8_BAR;
    }
    for (;;) {
        const bool has_next = S.next(ui + 1, nxt);
        const char* nA = has_next ? (const char*)g.A + (size_t)nxt.pm * tstepA : cA; const char* nB = has_next ? (const char*)g.Bt + (size_t)nxt.pn * tstepB : cB;
        for (int t = 0; t < nt; t += 2) {
            const bool last = (t == nt - 2);
            const char* a1 = cA + (size_t)(t + 1) * kstep;
            const char* a2 = last ? nA : cA + (size_t)(t + 2) * kstep; const char* b2 = last ? nB : cB + (size_t)(t + 2) * kstep;
            const char* a3 = a2 + kstep; const char* b3 = b2 + kstep;
            if (last && has_next) S.a_ready(nxt);
            if constexpr (Epi::HAS_PRE) { if (last) E.preload(pre, cur, wid, lane); }
            if constexpr (SP2) {
            PG8_LDB(B0, 0, 0); PG8_LDB(B1, 0, 1); PG8_SCHED; PG8_LDA(At, 0, 0); PG8_STAGE(PG8_SA(1, 1), a1 + hstepA, voffA);
            PG8_WAIT_V(8); PG8_WAIT_L(0); PG8_BAR; PG8_MMA(0, 0, At, B0); PG8_MMA(0, 1, At, B1); PG8_BAR; PG8_SCHED;
            PG8_LDA(At, 0, 1); PG8_STAGE(PG8_SB(0, 0), b2, voffB); PG8_STAGE(PG8_SB(0, 1), b2 + hstepB, voffB); PG8_STAGE(PG8_SA(0, 0), a2, voffA);
            PG8_WAIT_V(8); PG8_WAIT_L(0); PG8_BAR; PG8_MMA(1, 0, At, B0); PG8_MMA(1, 1, At, B1); PG8_BAR; PG8_SCHED;
            PG8_LDB(B0, 1, 0); PG8_LDB(B1, 1, 1); PG8_SCHED; PG8_LDA(At, 1, 0); PG8_STAGE(PG8_SA(0, 1), a2 + hstepA, voffA);
            PG8_WAIT_V(8); PG8_WAIT_L(0); PG8_BAR; PG8_MMA(0, 0, At, B0); PG8_MMA(0, 1, At, B1); PG8_BAR; PG8_SCHED;
            PG8_LDA(At, 1, 1); PG8_STAGE(PG8_SB(1, 0), b3, voffB); PG8_STAGE(PG8_SB(1, 1), b3 + hstepB, voffB); PG8_STAGE(PG8_SA(1, 0), a3, voffA);
            PG8_WAIT_V(8); PG8_WAIT_L(0); PG8_BAR; PG8_MMA(1, 0, At, B0); PG8_MMA(1, 1, At, B1); PG8_BAR; PG8_SCHED;
            } else {
            PG8_LDB(B0, 0, 0); PG8_SCHED; PG8_LDA(At, 0, 0); PG8_STAGE(PG8_SA(1, 1), a1 + hstepA, voffA);
            PG8_WAIT_L(8); PG8_BAR; PG8_WAIT_L(0); PG8_MMA(0, 0, At, B0); PG8_BAR; PG8_SCHED;
            PG8_LDB(B1, 0, 1); PG8_STAGE(PG8_SB(0, 0), b2, voffB);
            PG8_BAR; PG8_WAIT_L(0); PG8_MMA(0, 1, At, B1); PG8_BAR;
            PG8_LDA(At, 0, 1); PG8_STAGE(PG8_SA(0, 0), a2, voffA);
            PG8_BAR; PG8_WAIT_L(0); PG8_MMA(1, 0, At, B0); PG8_BAR; PG8_SCHED;
            PG8_STAGE(PG8_SB(0, 1), b2 + hstepB, voffB);
            PG8_WAIT_V(6); PG8_BAR; PG8_MMA(1, 1, At, B1); PG8_BAR;
            PG8_LDB(B0, 1, 0); PG8_SCHED; PG8_LDA(At, 1, 0); PG8_STAGE(PG8_SA(0, 1), a2 + hstepA, voffA);
            PG8_WAIT_L(8); PG8_BAR; PG8_WAIT_L(0); PG8_MMA(0, 0, At, B0); PG8_BAR; PG8_SCHED;
            PG8_LDB(B1, 1, 1); PG8_STAGE(PG8_SB(1, 0), b3, voffB);
            PG8_BAR; PG8_WAIT_L(0); PG8_MMA(0, 1, At, B1); PG8_BAR;
            PG8_LDA(At, 1, 1); PG8_STAGE(PG8_SA(1, 0), a3, voffA);
            PG8_BAR; PG8_WAIT_L(0); PG8_MMA(1, 0, At, B0); PG8_BAR; PG8_SCHED;
            PG8_STAGE(PG8_SB(1, 1), b3 + hstepB, voffB);
            PG8_WAIT_V(6); PG8_BAR; PG8_MMA(1, 1, At, B1); PG8_BAR;
            }
        }
        if constexpr (ALIGN_EPI) { if (wr == 0) PG8_BAR; }
        if constexpr (!Epi::AFTER_DRAIN) { if constexpr (Epi::HAS_PRE) E(acc, cur, wr, wc, fr, fq, pre); else E(acc, cur, wr, wc, fr, fq); S.done(cur); }
        if (!has_next) break;
#pragma unroll
        for (int a = 0; a < 2; ++a)
#pragma unroll
            for (int b = 0; b < 2; ++b)
#pragma unroll
                for (int m = 0; m < 4; ++m)
#pragma unroll
                    for (int n = 0; n < 2; ++n) acc[a][b][m][n] = (i32x4){0, 0, 0, 0};
        cur = nxt; cA = nA; cB = nB; ++ui;
        if constexpr (ALIGN_EPI) { if (wr == 1) PG8_BAR; }
    }
    PG8_WAIT_V(0);
    if constexpr (!ALIGN_EPI) { if (wr == 0) PG8_BAR; }
    PG8_BAR;
    if constexpr (Epi::AFTER_DRAIN) { E.fused(acc, cur, wr, wc, fr, fq, lds, wid, lane); S.done(cur); }
#undef PG8_SA
#undef PG8_SB
#undef PG8_STAGE
#undef PG8_LDA
#undef PG8_LDB
#undef PG8_MMA
#undef PG8_WAIT_V
#undef PG8_WAIT_L
#undef PG8_BAR
#undef PG8_SCHED
}
template <class Epi, class Sched, bool ALIGN_EPI = false, bool SP2 = false>
__device__ __forceinline__ void gemm_phase_dual(PG8_LAS unsigned char* lds, const Gemm g, const Sched& S, const Epi& E) {
    const int tid = threadIdx.x, wid = __builtin_amdgcn_readfirstlane(tid >> 6), lane = tid & 63, wr = wid >> 2, wc = wid & 3, fr = lane & 15, fq = lane >> 4;
    const int K = g.K, nt = K / BK;
    unsigned voffA[2], voffA2[2], voffB[2];
#pragma unroll
    for (int i = 0; i < 2; ++i) { int R, C; stage_rc(tid * 16 + i * 8192, R, C); const int Rb = Epi::PERM ? ((R & ~31) + perm32(R & 31)) : R;
        voffA[i] = (unsigned)(R * g.lda + C) * 2u; voffA2[i] = (unsigned)(R * g.lda2 + C) * 2u; voffB[i] = (unsigned)(Rb * K + C) * 2u; }
    const size_t kstep = (size_t)(BK * 2);
    const size_t hstepB = (size_t)HALF * K * 2, hstepA = (size_t)HALF * g.lda * 2, hstepA2 = (size_t)HALF * g.lda2 * 2; const int nt1 = g.K1 / BK;
    const size_t tstepA = 2 * hstepA, tstepA2 = 2 * hstepA2, tstepB = 2 * hstepB;
    const unsigned ldsw = (unsigned)wid * 1024u;
    const int aoff = lds_byte(wr * 64 + fr, fq * 8), boff = lds_byte(wc * 32 + fr, fq * 8);
#define PG8_SA(b, h) (((b) * 2 + (h)) * HTB)
#define PG8_SB(b, h) ((4 + (b) * 2 + (h)) * HTB)
#define PG8_STAGE(bufoff, gbase, voff) do { _Pragma("unroll") for (int _i = 0; _i < 2; ++_i) \
        __builtin_amdgcn_global_load_lds((const unsigned*)((const char*)(gbase) + (voff)[_i]), (PG8_LAS unsigned*)(lds + (bufoff) + ldsw + _i * 8192), 16, 0, 0); } while (0)
#define PG8_LDA(dst, b, h) do { _Pragma("unroll") for (int m = 0; m < 4; ++m) _Pragma("unroll") for (int k = 0; k < 2; ++k) dst[m][k] = *(const PG8_LAS bf16x8*)(lds + PG8_SA(b, h) + aoff + m * 2048 + k * 1024); } while (0)
#define PG8_LDB(dst, b, h) do { _Pragma("unroll") for (int n = 0; n < 2; ++n) _Pragma("unroll") for (int k = 0; k < 2; ++k) dst[n][k] = *(const PG8_LAS bf16x8*)(lds + PG8_SB(b, h) + boff + n * 2048 + k * 1024); } while (0)
#define PG8_MMA(ai, bj, At, Bt) do { __builtin_amdgcn_s_setprio(1); _Pragma("unroll") for (int m = 0; m < 4; ++m) _Pragma("unroll") for (int n = 0; n < 2; ++n) _Pragma("unroll") for (int k = 0; k < 2; ++k) \
        acc[ai][bj][m][n] = __builtin_amdgcn_mfma_f32_16x16x32_bf16(Bt[n][k], At[m][k], acc[ai][bj][m][n], 0, 0, 0); __builtin_amdgcn_s_setprio(0); } while (0)
#define PG8_WAIT_V(n) asm volatile("s_waitcnt vmcnt(" #n ")" ::: "memory")
#define PG8_WAIT_L(n) asm volatile("s_waitcnt lgkmcnt(" #n ")" ::: "memory")
#define PG8_BAR __builtin_amdgcn_s_barrier()
#define PG8_SCHED __builtin_amdgcn_sched_barrier(0)
    Unit cur, nxt; int ui = 0;
    if (!S.next(0, cur)) return;
    f32x4 acc[2][2][4][2];
#pragma unroll
    for (int a = 0; a < 2; ++a)
#pragma unroll
        for (int b = 0; b < 2; ++b)
#pragma unroll
            for (int m = 0; m < 4; ++m)
#pragma unroll
                for (int n = 0; n < 2; ++n) acc[a][b][m][n] = (f32x4){0.f, 0.f, 0.f, 0.f};
    bf16x8 At[4][2], B0[2][2], B1[2][2];
    const char* cA = (const char*)g.A + (size_t)cur.pm * tstepA; const char* cA2 = (const char*)g.A2 + (size_t)cur.pm * tstepA2; const char* cB = (const char*)g.Bt + (size_t)cur.pn * tstepB;
    S.a_ready(cur);
    if constexpr (SP2) {
        PG8_STAGE(PG8_SB(0, 0), cB, voffB); PG8_STAGE(PG8_SB(0, 1), cB + hstepB, voffB); PG8_STAGE(PG8_SA(0, 0), cA, voffA); PG8_STAGE(PG8_SA(0, 1), cA + hstepA, voffA);
        if (wr == 1) PG8_BAR;
        PG8_WAIT_V(2); PG8_BAR;
        PG8_STAGE(PG8_SB(1, 0), cB + kstep, voffB); PG8_STAGE(PG8_SA(1, 0), cA + kstep, voffA); PG8_STAGE(PG8_SB(1, 1), cB + hstepB + kstep, voffB);
        PG8_WAIT_V(6); PG8_BAR;
    } else {
        PG8_STAGE(PG8_SB(0, 0), cB, voffB); PG8_STAGE(PG8_SA(0, 0), cA, voffA); PG8_STAGE(PG8_SB(0, 1), cB + hstepB, voffB); PG8_STAGE(PG8_SA(0, 1), cA + hstepA, voffA);
        if (wr == 1) PG8_BAR;
        PG8_WAIT_V(4); PG8_BAR;
        PG8_STAGE(PG8_SB(1, 0), cB + kstep, voffB); PG8_STAGE(PG8_SA(1, 0), cA + kstep, voffA); PG8_STAGE(PG8_SB(1, 1), cB + hstepB + kstep, voffB);
        PG8_WAIT_V(6); PG8_BAR;
    }
    for (;;) {
        const bool has_next = S.next(ui + 1, nxt);
        const char* nA = has_next ? (const char*)g.A + (size_t)nxt.pm * tstepA : cA; const char* nA2 = has_next ? (const char*)g.A2 + (size_t)nxt.pm * tstepA2 : cA2; const char* nB = has_next ? (const char*)g.Bt + (size_t)nxt.pn * tstepB : cB;
        for (int t = 0; t < nt; t += 2) {
            const bool last = (t == nt - 2);
#define PG8_TILEP(T) ((T) < nt1 ? cA + (size_t)(T) * kstep : cA2 + (size_t)((T) - nt1) * kstep)
            if (t == nt1) E.mid(acc, cur, wr, wc, fr, fq);
            const char* a1 = PG8_TILEP(t + 1); const bool s1 = (t + 1) >= nt1;
            const char* a2 = last ? nA : PG8_TILEP(t + 2); const bool s2 = last ? false : (t + 2) >= nt1;
            const char* a3 = last ? nA + kstep : PG8_TILEP(t + 3); const bool s3 = last ? false : (t + 3) >= nt1;
            const char* b2 = last ? nB : cB + (size_t)(t + 2) * kstep; const char* b3 = b2 + kstep;
#define PG8_STAGE_A(bufoff, ptr, sec, half) do { const char* _p = (ptr) + ((half) ? ((sec) ? hstepA2 : hstepA) : (size_t)0); _Pragma("unroll") for (int _i = 0; _i < 2; ++_i) \
        __builtin_amdgcn_global_load_lds((const unsigned*)(_p + ((sec) ? voffA2[_i] : voffA[_i])), (PG8_LAS unsigned*)(lds + (bufoff) + ldsw + _i * 8192), 16, 0, 0); } while (0)
            if (last && has_next) S.a_ready(nxt);
            if constexpr (SP2) {
            PG8_LDB(B0, 0, 0); PG8_LDB(B1, 0, 1); PG8_SCHED; PG8_LDA(At, 0, 0); PG8_STAGE_A(PG8_SA(1, 1), a1, s1, 1);
            PG8_WAIT_V(8); PG8_WAIT_L(0); PG8_BAR; PG8_MMA(0, 0, At, B0); PG8_MMA(0, 1, At, B1); PG8_BAR; PG8_SCHED;
            PG8_LDA(At, 0, 1); PG8_STAGE(PG8_SB(0, 0), b2, voffB); PG8_STAGE(PG8_SB(0, 1), b2 + hstepB, voffB); PG8_STAGE_A(PG8_SA(0, 0), a2, s2, 0);
            PG8_WAIT_V(8); PG8_WAIT_L(0); PG8_BAR; PG8_MMA(1, 0, At, B0); PG8_MMA(1, 1, At, B1); PG8_BAR; PG8_SCHED;
            PG8_LDB(B0, 1, 0); PG8_LDB(B1, 1, 1); PG8_SCHED; PG8_LDA(At, 1, 0); PG8_STAGE_A(PG8_SA(0, 1), a2, s2, 1);
            PG8_WAIT_V(8); PG8_WAIT_L(0); PG8_BAR; PG8_MMA(0, 0, At, B0); PG8_MMA(0, 1, At, B1); PG8_BAR; PG8_SCHED;
            PG8_LDA(At, 1, 1); PG8_STAGE(PG8_SB(1, 0), b3, voffB); PG8_STAGE(PG8_SB(1, 1), b3 + hstepB, voffB); PG8_STAGE_A(PG8_SA(1, 0), a3, s3, 0);
            PG8_WAIT_V(8); PG8_WAIT_L(0); PG8_BAR; PG8_MMA(1, 0, At, B0); PG8_MMA(1, 1, At, B1); PG8_BAR; PG8_SCHED;
            }
        }
        if constexpr (ALIGN_EPI) { if (wr == 0) PG8_BAR; }
        if constexpr (!Epi::AFTER_DRAIN) { E(acc, cur, wr, wc, fr, fq); S.done(cur); }
        if (!has_next) break;
#pragma unroll
        for (int a = 0; a < 2; ++a)
#pragma unroll
            for (int b = 0; b < 2; ++b)
#pragma unroll
                for (int m = 0; m < 4; ++m)
#pragma unroll
                    for (int n = 0; n < 2; ++n) acc[a][b][m][n] = (f32x4){0.f, 0.f, 0.f, 0.f};
        cur = nxt; cA = nA; cA2 = nA2; cB = nB; ++ui;
        if constexpr (ALIGN_EPI) { if (wr == 1) PG8_BAR; }
    }
    PG8_WAIT_V(0);
    if constexpr (!ALIGN_EPI) { if (wr == 0) PG8_BAR; }
    PG8_BAR;
    if constexpr (Epi::AFTER_DRAIN) { E.fused(acc, cur, wr, wc, fr, fq, lds, wid, lane); S.done(cur); }
#undef PG8_TILEP
#undef PG8_STAGE_A
#undef PG8_SA
#undef PG8_SB
#undef PG8_STAGE
#undef PG8_LDA
#undef PG8_LDB
#undef PG8_MMA
#undef PG8_WAIT_V
#undef PG8_WAIT_L
#undef PG8_BAR
#undef PG8_SCHED
}
}
#define GAS __attribute__((address_space(1)))
#define LAS __attribute__((address_space(3)))
typedef unsigned short bf16;
typedef unsigned v4u __attribute__((ext_vector_type(4)));
typedef float f32x4 __attribute__((ext_vector_type(4)));
typedef short bf16x8 __attribute__((ext_vector_type(8)));
typedef GAS unsigned gu32;
typedef GAS unsigned long long gu64;
#define RLX_AGENT __ATOMIC_RELAXED, __HIP_MEMORY_SCOPE_AGENT
#define LDS_WAIT() asm volatile("s_waitcnt lgkmcnt(0)" ::: "memory")
#define VM_WAIT() asm volatile("s_waitcnt vmcnt(0)" ::: "memory")
__device__ __forceinline__ unsigned long long rt() { return __builtin_amdgcn_s_memrealtime(); }
__device__ __forceinline__ unsigned f2bf(float f) { unsigned u = __builtin_bit_cast(unsigned, f); return (u + 0x7fffu + ((u >> 16) & 1u)) >> 16; }
__device__ __forceinline__ unsigned pk2(float lo, float hi) { return f2bf(lo) | (f2bf(hi) << 16); }

#define XB_TMO      128
#define XB_XCNT(j)  (256  + 64 * (j))
#define XB_XSUB(j)  (1280 + 64 * (j))
#define XB_XGEN(j)  (2304 + 64 * (j))
#define XB_TOP      3328
#define XB_TOPGEN   3392
#define XCD_BAR_WORDS 3456
#define XB_SPIN_CAP (1u << 18)

__device__ __forceinline__ unsigned xb_ld(unsigned* p)              { return __hip_atomic_load(p, __ATOMIC_RELAXED, __HIP_MEMORY_SCOPE_AGENT); }
__device__ __forceinline__ unsigned xb_add(unsigned* p, unsigned v) { return __hip_atomic_fetch_add(p, v, __ATOMIC_RELAXED, __HIP_MEMORY_SCOPE_AGENT); }
__device__ __forceinline__ unsigned xb_xcc_id() { return (unsigned)__builtin_amdgcn_s_getreg((3 << 11) | 20) & 0xFu; }
#define XB_SPIN(cond, bar) do { unsigned _sp = 0; while (cond) { __builtin_amdgcn_s_sleep(1); \
    if ((++_sp & 255u) == 0u) { if (xb_ld(&(bar)[XB_TMO])) break; if (_sp > XB_SPIN_CAP) { atomicAdd(&(bar)[XB_TMO], 1u); break; } } } } while (0)

struct XcdBarrier {
    unsigned* bar; unsigned x;
    volatile LAS unsigned* st;
};

__device__ __forceinline__ XcdBarrier xcd_barrier_post(unsigned* bar, volatile LAS unsigned* st) {
    XcdBarrier b; b.bar = bar; b.x = xb_xcc_id(); b.st = st;
    if (threadIdx.x == 0) (void)xb_add(&bar[XB_XCNT(b.x)], 1u);
    return b;
}
__device__ __forceinline__ void xcd_barrier_complete(unsigned* bar, unsigned x, unsigned& nloc, unsigned& nx) {
    const unsigned G = gridDim.x * gridDim.y * gridDim.z;
    unsigned sum, cnt, mine, sp = 0u;
    for (;;) {
        sum = 0u; cnt = 0u; mine = 0u;
#pragma unroll
        for (unsigned j = 0; j < 16; ++j) { const unsigned c = xb_ld(&bar[XB_XCNT(j)]); sum += c; cnt += (c > 0u) ? 1u : 0u; mine = (j == x) ? c : mine; }
        if (sum == G) break;
        __builtin_amdgcn_s_sleep(1);
        if ((++sp & 255u) == 0u) { if (xb_ld(&bar[XB_TMO])) break; if (sp > XB_SPIN_CAP) { atomicAdd(&bar[XB_TMO], 1u); break; } }
    }
    nloc = mine > 0u ? mine : 1u; nx = cnt > 0u ? cnt : 1u;
}

__device__ __forceinline__ void xcd_barrier(const XcdBarrier& b) {
    asm volatile("s_waitcnt vmcnt(0)" ::: "memory");
    __syncthreads();
    if (threadIdx.x == 0) {
        unsigned* bar = b.bar;
        __builtin_amdgcn_s_waitcnt(0);
        unsigned nloc = b.st[0], nx = b.st[1];
        if (nloc == 0u) { xcd_barrier_complete(bar, b.x, nloc, nx); b.st[0] = nloc; b.st[1] = nx; }
        const unsigned old = xb_add(&bar[XB_XSUB(b.x)], 1u);
        const unsigned gen = old / nloc;
        if (old + 1u == (gen + 1u) * nloc) {
            __builtin_amdgcn_fence(__ATOMIC_RELEASE, "agent");
            asm volatile("s_waitcnt vmcnt(0)" ::: "memory");
            const unsigned og = xb_add(&bar[XB_TOP], 1u);
            const unsigned tg = og / nx;
            if (og + 1u == (tg + 1u) * nx) xb_add(&bar[XB_TOPGEN], 1u);
            else XB_SPIN(xb_ld(&bar[XB_TOPGEN]) == tg, bar);
            __builtin_amdgcn_fence(__ATOMIC_ACQUIRE, "agent");
            xb_add(&bar[XB_XGEN(b.x)], 1u);
            asm volatile("s_waitcnt vmcnt(0)" ::: "memory");
        } else {
            XB_SPIN(xb_ld(&bar[XB_XGEN(b.x)]) == gen, bar);
            __builtin_amdgcn_fence(__ATOMIC_ACQUIRE, "agent");
            asm volatile("s_waitcnt vmcnt(0)" ::: "memory");
        }
    }
    __syncthreads();
}

#ifndef PROBE_RB
#define PROBE_RB 128.0f
#endif
typedef float f32x2 __attribute__((ext_vector_type(2)));
constexpr int D = 1024, BATCH = 16, SEQ = 4096, M = BATCH * SEQ;
constexpr int INW = 6416, NP = 6400;
constexpr int LDP = pg8::LDP;
constexpr int C_AQ = 0, C_AK = 1024, C_AV = 1152, C_MQ = 1280, C_MK = 1792, C_MV = 2304, C_MO = 3328, C_GA = 4352, C_GM = 5376;
constexpr int C_ATT = 0;
constexpr int C_HMN = C_MV;
constexpr int C_MIX = 0;
constexpr int C_X1B = 1024;
constexpr int C_QB = 2048;
constexpr float EPS = 1e-6f, GATE_CAP = 15.0f;
constexpr int NEXP = 16384;

constexpr size_t MiB = 1u << 20;
constexpr size_t WS_CTL = 0, CTL_ZERO_BYTES = 1 * MiB;
constexpr size_t WS_W1T = 1 * MiB;
constexpr size_t WS_WAT = 14 * MiB, WS_WMT = 16 * MiB, WS_WOT = 18 * MiB, WS_WQT = 20 * MiB;
constexpr size_t WS_KEYS = 22 * MiB;
constexpr size_t WS_GATES = 23 * MiB;
constexpr size_t WS_ROPE = 27 * MiB;
constexpr size_t WS_SSQ = 31 * MiB;
constexpr size_t WS_DOWN = 36 * MiB, WS_UP = 52 * MiB;
constexpr size_t WS_SCD = 68 * MiB, WS_SCU = 69 * MiB;
constexpr size_t WS_IDX = 100 * MiB, WS_GATE = 132 * MiB;
constexpr size_t WS_COEF = 964 * MiB;
constexpr size_t WS_PROJ = 164 * MiB;
constexpr size_t WS_END = 996 * MiB;
constexpr int CW_BAR = 4096;
constexpr int CW_QUEUE = 64;
constexpr int CW_XRANK = 1024;
constexpr int CW_SWMAX = 131072;

constexpr int RING_OFF = 0, RING_BYTES = 131072;
constexpr int LDSCTL_OFF = RING_BYTES, MISC_OFF = LDSCTL_OFF + 320;
constexpr int LDS_BYTES = 147456;
constexpr int NWAVES = 8, NTHREADS = 512;

#define DPP_ROW_SHR(n) (0x110 + (n))
#define DPP_BCAST15 0x142
#define DPP_BCAST31 0x143
template <int CTRL, int ROW_MASK> __device__ __forceinline__ float dpp_f(float identity, float v) {
    return __builtin_bit_cast(float, __builtin_amdgcn_update_dpp(__builtin_bit_cast(int, identity), __builtin_bit_cast(int, v), CTRL, ROW_MASK, 0xf, false));
}
#define DPP_SCAN(v, identity, OP) do { \
    v = OP(v, (dpp_f<DPP_ROW_SHR(1), 0xf>(identity, v))); v = OP(v, (dpp_f<DPP_ROW_SHR(2), 0xf>(identity, v))); v = OP(v, (dpp_f<DPP_ROW_SHR(4), 0xf>(identity, v))); v = OP(v, (dpp_f<DPP_ROW_SHR(8), 0xf>(identity, v))); \
    v = OP(v, (dpp_f<DPP_BCAST15, 0xa>(identity, v))); v = OP(v, (dpp_f<DPP_BCAST31, 0xc>(identity, v))); } while (0)
#define DPP_ADD(a, b) ((a) + (b))
#define DPP_MAX(a, b) fmaxf((a), (b))
__device__ __forceinline__ float lane_bcast(float v, int l) { return __builtin_bit_cast(float, __builtin_amdgcn_readlane(__builtin_bit_cast(int, v), l)); }
__device__ __forceinline__ float sum8_dpp(float v, int lane) {
    v += __builtin_bit_cast(float, __builtin_amdgcn_update_dpp(0, __builtin_bit_cast(int, v), 0xB1, 0xf, 0xf, true));
    v += __builtin_bit_cast(float, __builtin_amdgcn_update_dpp(0, __builtin_bit_cast(int, v), 0x4E, 0xf, 0xf, true));
    const float up = __builtin_bit_cast(float, __builtin_amdgcn_update_dpp(0, __builtin_bit_cast(int, v), 0x104, 0xf, 0xf, true));
    const float dn = __builtin_bit_cast(float, __builtin_amdgcn_update_dpp(0, __builtin_bit_cast(int, v), 0x114, 0xf, 0xf, true));
    return v + ((lane & 4) ? dn : up);
}
__device__ __forceinline__ float wave_sum(float v) { DPP_SCAN(v, 0.f, DPP_ADD); return lane_bcast(v, 63); }
__device__ __forceinline__ float wave_max(float v) { DPP_SCAN(v, -INFINITY, DPP_MAX); return lane_bcast(v, 63); }
__device__ __forceinline__ float bf2f(bf16 b) { return __builtin_bit_cast(float, (unsigned)b << 16); }

struct Args { const void* in[18]; float* out; unsigned char* ws; int ph_lo, ph_hi; };

struct Frame {
    LAS unsigned char* lds;
    volatile LAS unsigned* MISC;
    gu32* ctl;
    int tid, lane, wave, G;
};

__device__ __forceinline__ void p0_transpose_item(const float* W, int ldw, int srccol0, int k0, bf16* WT, int K, int dstrow0, const float* kscale, LAS float* scr, int lane, int kdst = 0) {
#pragma unroll 8
    for (int i = 0; i < 32; ++i) { const int kk = 2 * i + (lane >> 5); float v = W[(size_t)(k0 + kk) * ldw + srccol0 + (lane & 31)]; if (kscale) v *= kscale[k0 + kk]; scr[kk * 33 + (lane & 31)] = v; }
    LDS_WAIT(); asm volatile("" ::: "memory");
    const int c = lane & 7;
#pragma unroll
    for (int j = 0; j < 4; ++j) { const int n = (lane >> 3) + 8 * j; const LAS float* s = scr + (8 * c) * 33 + n;
        v4u o; o.x = pk2(s[0 * 33], s[1 * 33]); o.y = pk2(s[2 * 33], s[3 * 33]); o.z = pk2(s[4 * 33], s[5 * 33]); o.w = pk2(s[6 * 33], s[7 * 33]);
        *(GAS v4u*)(WT + (size_t)(dstrow0 + n) * K + kdst + k0 + 8 * c) = o; }
    LDS_WAIT(); asm volatile("" ::: "memory");
}

constexpr int TQ_UNITS = 2 * NEXP / 128;
__device__ __forceinline__ void quant_tables_unit(Frame& F, const Args& a, int unit) {
    const float* g2 = (const float*)a.in[13]; const float* pdown = (const float*)a.in[16]; const float* pup = (const float*)a.in[17];
    unsigned char* ws = a.ws;
    const int row0 = unit * 128 + F.wave * 16;
    f32x4 nrow[4];
    { const float* src = (row0 >= NEXP ? pup + (size_t)(row0 - NEXP) * D : pdown + (size_t)row0 * D) + 16 * F.lane;
#pragma unroll
      for (int q = 0; q < 4; ++q) nrow[q] = *(const f32x4*)(src + 4 * q); }
    f32x4 g2v[4];
#pragma unroll
    for (int q = 0; q < 4; ++q) g2v[q] = *(const f32x4*)(g2 + 16 * F.lane + 4 * q);
#pragma unroll 1
    for (int i = 0; i < 16; ++i) {
        const int row = row0 + i;
        const bool up = row >= NEXP; const int e = up ? row - NEXP : row;
        f32x4 cur[4];
#pragma unroll
        for (int q = 0; q < 4; ++q) cur[q] = nrow[q];
        { const int rn = (i + 1 < 16) ? row + 1 : row; const float* src = (rn >= NEXP ? pup + (size_t)(rn - NEXP) * D : pdown + (size_t)rn * D) + 16 * F.lane;
#pragma unroll
          for (int q = 0; q < 4; ++q) nrow[q] = *(const f32x4*)(src + 4 * q); }
        float v[16]; float am = 0.f;
#pragma unroll
        for (int q = 0; q < 4; ++q) { const f32x4 a4 = cur[q]; f32x4 s4 = {1.f, 1.f, 1.f, 1.f}; if (!up) s4 = g2v[q];
#pragma unroll
            for (int k = 0; k < 4; ++k) { v[4 * q + k] = a4[k] * s4[k]; am = fmaxf(am, fabsf(v[4 * q + k])); } }
        am = fmaxf(wave_max(am), 1e-30f);
        const float sc = up ? am * (1.0f / 448.0f) : am * (1.0f / 127.0f), isc = up ? 448.0f / am : 127.0f / am;
        unsigned w[4];
#pragma unroll
        for (int q = 0; q < 4; ++q) {
            if (up) { int pk = 0; pk = __builtin_amdgcn_cvt_pk_fp8_f32(v[4 * q] * isc, v[4 * q + 1] * isc, pk, false); pk = __builtin_amdgcn_cvt_pk_fp8_f32(v[4 * q + 2] * isc, v[4 * q + 3] * isc, pk, true); w[q] = (unsigned)pk; }
            else { unsigned acc4 = 0u;
#pragma unroll
                for (int k = 0; k < 4; ++k) { int qi = (int)__builtin_rintf(v[4 * q + k] * isc); qi = qi < -127 ? -127 : (qi > 127 ? 127 : qi); acc4 |= (unsigned)(qi & 0xff) << (8 * k); }
                w[q] = acc4; } }
        unsigned char* dstp = up ? (unsigned char*)(ws + WS_UP) + (size_t)(F.lane >> 3) * ((size_t)NEXP * 128) + (size_t)e * 128 + 16 * (F.lane & 7) : (unsigned char*)(ws + WS_DOWN) + (size_t)e * D + 16 * F.lane;
        *(v4u*)dstp = (v4u){w[0], w[1], w[2], w[3]};
        if (F.lane == 0) ((float*)(ws + (up ? WS_SCU : WS_SCD)))[e] = sc;
    }
}
__device__ __forceinline__ void p0_prologue(Frame& F, const Args& a, int pass) {
    const float* x = (const float*)a.in[0]; const int* pos = (const int*)a.in[1]; const float* g1 = (const float*)a.in[2]; const float* w_in = (const float*)a.in[3];
    const float* ibias = (const float*)a.in[4]; const float* fbias = (const float*)a.in[5];
    const float* wa = (const float*)a.in[10]; const float* wm = (const float*)a.in[11]; const float* wo = (const float*)a.in[12];
    const float* g2 = (const float*)a.in[13]; const float* wq = (const float*)a.in[14]; const float* skeys = (const float*)a.in[15];
    const float* pdown = (const float*)a.in[16]; const float* pup = (const float*)a.in[17];
    unsigned char* ws = a.ws;
    bf16* WAT = (bf16*)(ws + WS_WAT); bf16* WMT = (bf16*)(ws + WS_WMT); bf16* WOT = (bf16*)(ws + WS_WOT); bf16* WQT = (bf16*)(ws + WS_WQT);
    bf16* KEYS = (bf16*)(ws + WS_KEYS); float* GATES = (float*)(ws + WS_GATES); float* ROPE = (float*)(ws + WS_ROPE);
    unsigned char* XN8 = (unsigned char*)a.out; float* SX = (float*)(ws + WS_SSQ);
    const int gw = blockIdx.x * NWAVES + F.wave, NGW = F.G * NWAVES;
    const int gt = blockIdx.x * NTHREADS + F.tid, NGT = F.G * NTHREADS;
    LAS float* scr = (LAS float*)(F.lds + RING_OFF + F.wave * 8704);
    constexpr int I_1 = 16 * 200, I_S = 16 * 32;
    gu32* SWMAX = F.ctl + CW_SWMAX;
    auto w1_src = [](int n0) { int src = n0 + (n0 >= 3328 ? 16 : 0); if (n0 >= C_GA) { const int o = n0 - C_GA, j = o >> 8, hf = (o >> 7) & 1, wi = o & 127; src = (hf ? 5392 : 4368) + 128 * j + wi; } return src; };
    if (pass == 0) {
        for (int it = gw; it < I_1; it += NGW) {
            const int kb = it / 200, nb = it % 200, n0 = nb * 32, src = w1_src(n0);
            float mx = 0.f;
#pragma unroll 8
            for (int i = 0; i < 32; ++i) { const int kk = 2 * i + (F.lane >> 5); mx = fmaxf(mx, fabsf(w_in[(size_t)(kb * 64 + kk) * INW + src + (F.lane & 31)])); }
            mx = fmaxf(mx, __shfl_xor(mx, 32));
            if (F.lane < 32) __hip_atomic_fetch_max(SWMAX + n0 + F.lane, __builtin_bit_cast(unsigned, mx), RLX_AGENT);
        }
        for (int it = gw; it < 4 * I_S; it += NGW) {
            const int which = it / I_S, r = it % I_S, kb = r / 32, nb = r % 32;
            const float* W = which == 0 ? wa : which == 1 ? wm : which == 2 ? wo : wq;
            if (which < 2) p0_transpose_item(W, D, nb * 32, kb * 64, WAT, 2 * D, nb * 32, nullptr, scr, F.lane, which * D);
            else {
                const bool isq = which == 3; float mx = 0.f;
#pragma unroll 8
                for (int i = 0; i < 32; ++i) { const int kk = kb * 64 + 2 * i + (F.lane >> 5); mx = fmaxf(mx, fabsf(W[(size_t)kk * D + nb * 32 + (F.lane & 31)] * (isq ? g2[kk] : 1.f))); }
                mx = fmaxf(mx, __shfl_xor(mx, 32));
                if (F.lane < 32) __hip_atomic_fetch_max(SWMAX + NP + (isq ? 0 : D) + nb * 32 + F.lane, __builtin_bit_cast(unsigned, mx), RLX_AGENT);
            }
        }
    } else {
        unsigned char* W1T8 = (unsigned char*)(ws + WS_W1T); unsigned char* WQT8 = (unsigned char*)(ws + WS_WQT); unsigned char* WOT8 = (unsigned char*)(ws + WS_WOT);
        for (int it = gw; it < I_1 + 2 * I_S; it += NGW) {
            const bool iso = it >= I_1 + I_S, isq = it >= I_1 && !iso, sq = it >= I_1; const int r2i = iso ? it - I_1 - I_S : (isq ? it - I_1 : it);
            const int kb = sq ? r2i / 32 : r2i / 200, nb = sq ? r2i % 32 : r2i % 200, n0 = nb * 32, src = sq ? n0 : w1_src(n0);
            const float* Wsrc = iso ? wo : (isq ? wq : w_in); const int ldw = sq ? D : INW;
#pragma unroll 8
            for (int i = 0; i < 32; ++i) { const int kk = 2 * i + (F.lane >> 5); float v = Wsrc[(size_t)(kb * 64 + kk) * ldw + src + (F.lane & 31)]; if (isq) v *= g2[kb * 64 + kk]; scr[kk * 33 + (F.lane & 31)] = v; }
            LDS_WAIT(); asm volatile("" ::: "memory");
            const int n = F.lane >> 1, hf = F.lane & 1;
            const float isc = 127.0f / fmaxf(__builtin_bit_cast(float, __hip_atomic_load(SWMAX + (iso ? NP + D : (isq ? NP : 0)) + n0 + n, RLX_AGENT)), 1e-30f);
            unsigned w[8];
#pragma unroll
            for (int q = 0; q < 8; ++q) { unsigned a4 = 0u;
#pragma unroll
                for (int k = 0; k < 4; ++k) a4 |= (unsigned)((int)__builtin_rintf(scr[(32 * hf + 4 * q + k) * 33 + n] * isc) & 0xff) << (8 * k);
                w[q] = a4; }
            unsigned char* dst = (iso ? WOT8 : (isq ? WQT8 : W1T8)) + (size_t)(n0 + n) * D + kb * 64 + 32 * hf;
            *(GAS v4u*)(dst) = (v4u){w[0], w[1], w[2], w[3]}; *(GAS v4u*)(dst + 16) = (v4u){w[4], w[5], w[6], w[7]};
            LDS_WAIT(); asm volatile("" ::: "memory");
        }
        return;
    }
    for (int c = gt; c < 8 * 2 * 128 * 64 / 8; c += NGT) {
        const size_t e0 = (size_t)c * 8; const f32x4 b0 = *(const f32x4*)(skeys + e0), b1 = *(const f32x4*)(skeys + e0 + 4);
        v4u p; p.x = pk2(b0[0], b0[1]); p.y = pk2(b0[2], b0[3]); p.z = pk2(b1[0], b1[1]); p.w = pk2(b1[2], b1[3]);
        *(v4u*)(KEYS + e0) = p;
    }
    for (int c = gt; c < M * 8; c += NGT) {
        const int t = c >> 3, i = c & 7;
        const float inv_freq = i == 0 ? 1.000000000e+00f : i == 1 ? 1.939227432e-01f : i == 2 ? 3.760603070e-02f : i == 3 ? 7.292664610e-03f : i == 4 ? 1.414213562e-03f : i == 5 ? 2.742481884e-04f : i == 6 ? 5.318296098e-05f : 1.031338616e-05f;
        const float angf = (float)pos[t] * inv_freq;
        const double rev = (double)angf * 0.15915494309189535;
        const float fr = (float)(rev - __builtin_rint(rev));
        ROPE[(size_t)t * 16 + i] = __builtin_amdgcn_cosf(fr); ROPE[(size_t)t * 16 + 8 + i] = __builtin_amdgcn_sinf(fr);
    }
    {
        __syncthreads();
        LAS float* wg = (LAS float*)(F.lds + RING_OFF);
        for (int i = F.tid; i < 16 * 1024; i += NTHREADS) { const int c = i & 15, k = i >> 4; wg[c * 1024 + k] = w_in[(size_t)k * INW + 3328 + c]; }
        __syncthreads();
        const int gc = (F.lane >> 1) & 15;
        const float bias = gc < 8 ? ibias[gc] : fbias[gc - 8];
        const f32x4 gg[4] = {*(const f32x4*)(g1 + 4 * F.lane), *(const f32x4*)(g1 + 256 + 4 * F.lane), *(const f32x4*)(g1 + 512 + 4 * F.lane), *(const f32x4*)(g1 + 768 + 4 * F.lane)};
        f32x4 nx[2][4];
#define P0_LOADROW(R, ROW) do { const float* xr_ = x + (size_t)(ROW) * D + 4 * F.lane; \
        asm volatile("global_load_dwordx4 %0, %4, off\n\tglobal_load_dwordx4 %1, %4, off offset:1024\n\tglobal_load_dwordx4 %2, %4, off offset:2048\n\tglobal_load_dwordx4 %3, %4, off offset:3072" \
                     : "=&v"(nx[R][0]), "=&v"(nx[R][1]), "=&v"(nx[R][2]), "=&v"(nx[R][3]) : "v"(xr_) : "memory"); } while (0)
#define P0_WAITROW() asm volatile("s_waitcnt vmcnt(0)" : "+v"(nx[0][0]), "+v"(nx[0][1]), "+v"(nx[0][2]), "+v"(nx[0][3]), "+v"(nx[1][0]), "+v"(nx[1][1]), "+v"(nx[1][2]), "+v"(nx[1][3]) :: "memory")
        P0_LOADROW(0, gw < M ? gw : 0); P0_LOADROW(1, gw + NGW < M ? gw + NGW : 0); P0_WAITROW();
#pragma unroll 1
        for (int m = gw; m < M; m += 2 * NGW) {
            const bool has1 = m + NGW < M;
            f32x4 v[2][4];
#pragma unroll
            for (int r = 0; r < 2; ++r)
#pragma unroll
                for (int j = 0; j < 4; ++j) v[r][j] = nx[r][j];
            P0_LOADROW(0, (m + 2 * NGW < M) ? m + 2 * NGW : m); P0_LOADROW(1, (m + 3 * NGW < M) ? m + 3 * NGW : m);
#pragma unroll
            for (int r = 0; r < 2; ++r) {
                float s = 0.f;
#pragma unroll
                for (int j = 0; j < 4; ++j) s += (v[r][j].x * v[r][j].x + v[r][j].y * v[r][j].y) + (v[r][j].z * v[r][j].z + v[r][j].w * v[r][j].w);
                const float rn = __builtin_amdgcn_rsqf(wave_sum(s) * (1.f / D) + EPS);
                float am = 0.f;
#pragma unroll
                for (int j = 0; j < 4; ++j) { v[r][j] = v[r][j] * rn * gg[j]; am = fmaxf(fmaxf(am, fmaxf(fabsf(v[r][j].x), fabsf(v[r][j].y))), fmaxf(fabsf(v[r][j].z), fabsf(v[r][j].w))); }
                am = fmaxf(wave_max(am), 1e-30f);
                const float isx = 127.0f / am;
                if (r == 0 || has1) {
                    const int mr = m + r * NGW;
                    GAS unsigned* o4 = (GAS unsigned*)(XN8 + (size_t)mr * D) + F.lane;
#pragma unroll
                    for (int j = 0; j < 4; ++j) {
                        unsigned w8 = 0u;
                        w8 = __builtin_amdgcn_cvt_pk_u8_f32(__builtin_fmaf(v[r][j].x, isx, PROBE_RB), 0, w8); w8 = __builtin_amdgcn_cvt_pk_u8_f32(__builtin_fmaf(v[r][j].y, isx, PROBE_RB), 1, w8);
                        w8 = __builtin_amdgcn_cvt_pk_u8_f32(__builtin_fmaf(v[r][j].z, isx, PROBE_RB), 2, w8); w8 = __builtin_amdgcn_cvt_pk_u8_f32(__builtin_fmaf(v[r][j].w, isx, PROBE_RB), 3, w8);
                        o4[64 * j] = w8 ^ 0x80808080u; }
                    if (F.lane == 0) SX[mr] = am * (1.0f / 127.0f);
                }
            }
            float p[2][16];
#pragma unroll
            for (int c = 0; c < 16; ++c) {
                f32x2 a0 = {0.f, 0.f}, a1 = {0.f, 0.f};
#pragma unroll
                for (int j = 0; j < 4; ++j) { const f32x4 w = *(const LAS f32x4*)(wg + c * 1024 + 256 * j + 4 * F.lane); const f32x2 wl = {w.x, w.y}, wh = {w.z, w.w};
                    a0 = __builtin_elementwise_fma((f32x2){v[0][j].x, v[0][j].y}, wl, a0); a0 = __builtin_elementwise_fma((f32x2){v[0][j].z, v[0][j].w}, wh, a0);
                    a1 = __builtin_elementwise_fma((f32x2){v[1][j].x, v[1][j].y}, wl, a1); a1 = __builtin_elementwise_fma((f32x2){v[1][j].z, v[1][j].w}, wh, a1); }
                p[0][c] = a0.x + a0.y; p[1][c] = a1.x + a1.y;
                if ((c & 3) == 3) __builtin_amdgcn_sched_barrier(0);
            }
            float q[16];
            { const bool up = (F.lane & 32) != 0;
#pragma unroll
              for (int c = 0; c < 16; ++c) { const float send = up ? p[0][c] : p[1][c], keep = up ? p[1][c] : p[0][c]; q[c] = keep + __shfl_xor(send, 32); } }
            { const bool up = (F.lane & 16) != 0;
#pragma unroll
              for (int c = 0; c < 8; ++c) { const float send = up ? q[c] : q[c + 8], keep = up ? q[c + 8] : q[c]; q[c] = keep + __shfl_xor(send, 16); } }
            { const bool up = (F.lane & 8) != 0;
#pragma unroll
              for (int c = 0; c < 4; ++c) { const float send = up ? q[c] : q[c + 4], keep = up ? q[c + 4] : q[c]; q[c] = keep + __shfl_xor(send, 8); } }
            { const bool up = (F.lane & 4) != 0;
#pragma unroll
              for (int c = 0; c < 2; ++c) { const float send = up ? q[c] : q[c + 2], keep = up ? q[c + 2] : q[c]; q[c] = keep + __shfl_xor(send, 4); } }
            { const bool up = (F.lane & 2) != 0; const float send = up ? q[0] : q[1], keep = up ? q[1] : q[0]; q[0] = keep + __shfl_xor(send, 2); }
            P0_WAITROW();
            float g = q[0] + __shfl_xor(q[0], 1) + bias;
            { const float e2 = __builtin_amdgcn_exp2f(g * (2.0f * 1.4426950408889634f / GATE_CAP)); g = GATE_CAP * (1.0f - 2.0f * __builtin_amdgcn_rcpf(e2 + 1.0f)); }
            if (gc >= 8) { const float y = __builtin_amdgcn_exp2f(-fabsf(g) * 1.4426950408889634f);
                const float l1p = y < 1e-3f ? y * (1.0f - 0.5f * y) : 0.6931471805599453f * __builtin_amdgcn_logf(1.0f + y);
                g = fminf(g, 0.f) - l1p; }
            { const int rr = F.lane >> 5; if ((F.lane & 1) == 0 && (rr == 0 || has1)) GATES[(size_t)(m + rr * NGW) * 16 + gc] = g; }
        }
#undef P0_LOADROW
#undef P0_WAITROW
        __syncthreads();
    }
}

typedef float f32x16 __attribute__((ext_vector_type(16)));
typedef unsigned u32x2 __attribute__((ext_vector_type(2)));
constexpr int ATT_KS = 0, ATT_KROW = 144, ATT_VT = 256 * ATT_KROW, ATT_VROW = 520, ATT_LDS = ATT_VT + 64 * ATT_VROW;
constexpr float LOG2E = 1.4426950408889634f;
__device__ __forceinline__ void attn_unit(Frame& F, bf16* ATTC, bf16* PROJ, const float* __restrict__ ROPE, const float* __restrict__ qg, const float* __restrict__ kg, const float* __restrict__ sinks, int unit) {
    const int kvh = unit & 1, j = (unit >> 1) & 31, b = unit >> 6;
    const size_t t0 = (size_t)b * SEQ + (size_t)j * 128;
    LAS unsigned char* Ks = F.lds + ATT_KS; LAS unsigned char* Vt = F.lds + ATT_VT;
    __syncthreads();
    {
        const int p = F.tid & 7, rr = F.tid >> 3;
        float g[8];
#pragma unroll
        for (int e = 0; e < 8; ++e) g[e] = kg[p * 8 + e];
#pragma unroll
        for (int pass = 0; pass < 4; ++pass) {
            const int kk = pass * 64 + rr;
            pg8::u32x4 w = {0u, 0u, 0u, 0u};
            if (j > 0 || kk >= 128) {
                const size_t tok = t0 - 128 + kk;
                float v[8]; pg8::unpack8(*(const pg8::u32x4*)(PROJ + tok * LDP + C_AK + kvh * 64 + p * 8), v);
                float ss = 0.f;
#pragma unroll
                for (int e = 0; e < 8; ++e) ss += v[e] * v[e];
                ss += __shfl_xor(ss, 1); ss += __shfl_xor(ss, 2); ss += __shfl_xor(ss, 4);
                const float r = __builtin_amdgcn_rsqf(ss * (1.0f / 64.0f) + EPS);
#pragma unroll
                for (int e = 0; e < 8; ++e) v[e] = v[e] * r * g[e];
                float pt[8];
#pragma unroll
                for (int e = 0; e < 8; ++e) pt[e] = __shfl_xor(v[e], 1);
                if (p < 2) {
                    const f32x4 c0 = *(const f32x4*)(ROPE + tok * 16), c1 = *(const f32x4*)(ROPE + tok * 16 + 4), s0 = *(const f32x4*)(ROPE + tok * 16 + 8), s1 = *(const f32x4*)(ROPE + tok * 16 + 12);
                    const float sg = p == 0 ? -1.f : 1.f;
#pragma unroll
                    for (int e = 0; e < 4; ++e) { v[e] = v[e] * c0[e] + sg * pt[e] * s0[e]; v[4 + e] = v[4 + e] * c1[e] + sg * pt[4 + e] * s1[e]; }
                }
                w = pg8::pack8(v);
            }
            *(LAS pg8::u32x4*)(Ks + kk * ATT_KROW + p * 16) = w;
        }
    }
    {
        const int kp = F.tid & 127, dg = F.tid >> 7;
        float a[16], c[16];
        if (j > 0 || kp >= 64) {
            const size_t tok = t0 - 128 + 2 * kp;
            const bf16* src = PROJ + tok * LDP + C_AV + kvh * 64 + dg * 16;
            float t8[8];
            pg8::unpack8(*(const pg8::u32x4*)(src), t8);
#pragma unroll
            for (int e = 0; e < 8; ++e) a[e] = t8[e];
            pg8::unpack8(*(const pg8::u32x4*)(src + 8), t8);
#pragma unroll
            for (int e = 0; e < 8; ++e) a[8 + e] = t8[e];
            pg8::unpack8(*(const pg8::u32x4*)(src + LDP), t8);
#pragma unroll
            for (int e = 0; e < 8; ++e) c[e] = t8[e];
            pg8::unpack8(*(const pg8::u32x4*)(src + LDP + 8), t8);
#pragma unroll
            for (int e = 0; e < 8; ++e) c[8 + e] = t8[e];
        } else {
#pragma unroll
            for (int e = 0; e < 16; ++e) { a[e] = 0.f; c[e] = 0.f; }
        }
#pragma unroll
        for (int e = 0; e < 16; ++e) *(LAS unsigned*)(Vt + (dg * 16 + e) * ATT_VROW + kp * 4) = pg8::cvt_pk_bf16(a[e], c[e]);
    }
    __syncthreads();
    const int h = kvh * 8 + F.wave, r = F.lane & 31, hh = F.lane >> 5;
    const float sink2 = sinks[h] * LOG2E;
    float gq[32];
#pragma unroll
    for (int s = 0; s < 4; ++s)
#pragma unroll
        for (int e = 0; e < 8; ++e) gq[s * 8 + e] = qg[16 * s + 8 * hh + e];
#pragma unroll 1
    for (int qi = 0; qi < 4; ++qi) {
        const size_t tok = t0 + 32 * qi + r;
        bf16* qrow = PROJ + tok * LDP + C_AQ + h * 64;
        float qv[32]; float ss = 0.f;
#pragma unroll
        for (int s = 0; s < 4; ++s) { float t8[8]; pg8::unpack8(*(const pg8::u32x4*)(qrow + 16 * s + 8 * hh), t8);
#pragma unroll
            for (int e = 0; e < 8; ++e) { qv[s * 8 + e] = t8[e]; ss += t8[e] * t8[e]; } }
        ss += __shfl_xor(ss, 32);
        const float rq = __builtin_amdgcn_rsqf(ss * (1.0f / 64.0f) + EPS) * (0.125f * LOG2E);
#pragma unroll
        for (int e = 0; e < 32; ++e) qv[e] = qv[e] * rq * gq[e];
        {
            const f32x4 c0 = *(const f32x4*)(ROPE + tok * 16), c1 = *(const f32x4*)(ROPE + tok * 16 + 4), s0 = *(const f32x4*)(ROPE + tok * 16 + 8), s1 = *(const f32x4*)(ROPE + tok * 16 + 12);
            const float sg = hh == 0 ? -1.f : 1.f;
            float pt[8];
#pragma unroll
            for (int e = 0; e < 8; ++e) pt[e] = __shfl_xor(qv[e], 32);
#pragma unroll
            for (int e = 0; e < 4; ++e) { qv[e] = qv[e] * c0[e] + sg * pt[e] * s0[e]; qv[4 + e] = qv[4 + e] * c1[e] + sg * pt[4 + e] * s1[e]; }
        }
        bf16x8 qf[4];
#pragma unroll
        for (int s = 0; s < 4; ++s) { float t8[8];
#pragma unroll
            for (int e = 0; e < 8; ++e) t8[e] = qv[s * 8 + e];
            qf[s] = __builtin_bit_cast(bf16x8, pg8::pack8(t8)); }
        f32x16 S[5];
        float mx = sink2;
#pragma unroll
        for (int ii = 0; ii < 5; ++ii) {
            const int jk = qi + ii;
            f32x16 acc = {};
            const LAS unsigned char* kb = Ks + (32 * jk + r) * ATT_KROW + hh * 16;
#pragma unroll
            for (int s = 0; s < 4; ++s) acc = __builtin_amdgcn_mfma_f32_32x32x16_bf16(*(const LAS bf16x8*)(kb + s * 32), qf[s], acc, 0, 0, 0);
            const bool dead = (j == 0 && jk < 4);
#pragma unroll
            for (int i = 0; i < 16; ++i) {
                const int krow = (i & 3) + 8 * (i >> 2) + 4 * hh;
                bool ok = !dead;
                if (ii == 0) ok = ok && (krow > r);
                if (ii == 4) ok = ok && (krow <= r);
                acc[i] = ok ? acc[i] : -INFINITY;
                mx = fmaxf(mx, acc[i]);
            }
            S[ii] = acc;
        }
        mx = fmaxf(mx, __shfl_xor(mx, 32));
        float den = 0.f;
#pragma unroll
        for (int ii = 0; ii < 5; ++ii)
#pragma unroll
            for (int i = 0; i < 16; ++i) { const float pv = __builtin_amdgcn_exp2f(S[ii][i] - mx); S[ii][i] = pv; den += pv; }
        den += __shfl_xor(den, 32);
        den += __builtin_amdgcn_exp2f(sink2 - mx);
        f32x16 o[2] = {};
#pragma unroll
        for (int ii = 0; ii < 5; ++ii) {
            const int jk = qi + ii;
#pragma unroll
            for (int sp = 0; sp < 2; ++sp) {
                float t8[8];
#pragma unroll
                for (int e = 0; e < 8; ++e) t8[e] = S[ii][8 * sp + e];
                const bf16x8 pb = __builtin_bit_cast(bf16x8, pg8::pack8(t8));
                const int kbase = 32 * jk + 16 * sp + 4 * hh;
#pragma unroll
                for (int dt = 0; dt < 2; ++dt) {
                    const LAS unsigned char* vp = Vt + (32 * dt + r) * ATT_VROW + kbase * 2;
                    const u32x2 lo = *(const LAS u32x2*)(vp), hi2 = *(const LAS u32x2*)(vp + 16);
                    const pg8::u32x4 av = {lo.x, lo.y, hi2.x, hi2.y};
                    o[dt] = __builtin_amdgcn_mfma_f32_32x32x16_bf16(__builtin_bit_cast(bf16x8, av), pb, o[dt], 0, 0, 0);
                }
            }
        }
        const float inv = __builtin_amdgcn_rcpf(den);
#pragma unroll
        for (int dt = 0; dt < 2; ++dt)
#pragma unroll
            for (int g4 = 0; g4 < 4; ++g4) {
                u32x2 w; w.x = pg8::cvt_pk_bf16(o[dt][4 * g4] * inv, o[dt][4 * g4 + 1] * inv); w.y = pg8::cvt_pk_bf16(o[dt][4 * g4 + 2] * inv, o[dt][4 * g4 + 3] * inv);
                *(u32x2*)(ATTC + tok * 1024 + h * 64 + 32 * dt + 8 * g4 + 4 * hh) = w;
            }
    }
}


constexpr int ML_ROW = 144;
constexpr int ML_QS = 0, ML_KS = ML_QS + 64 * ML_ROW, ML_KT = ML_KS + 64 * ML_ROW, ML_VT = ML_KT + 64 * ML_ROW, ML_AA = ML_VT + 128 * ML_ROW, ML_NN = ML_AA + 256, ML_HB = ML_NN + 512;
constexpr int ML_HROW = 528, ML_GN = ML_HB + 64 * ML_HROW, ML_LDS = ML_GN + 512;
__device__ __forceinline__ void mlstm_unit(Frame& F, bf16* PROJ, const float* __restrict__ GATES, const float* __restrict__ mog, int unit) {
    const int b = unit >> 3, h = unit & 7;
    const int tid = F.tid, lane = F.lane, r = lane & 31, hh = lane >> 5, vi = F.wave >> 1, ti = F.wave & 1;
    LAS unsigned char* L = F.lds;
    LAS float* AA = (LAS float*)(L + ML_AA); LAS float* NN = (LAS float*)(L + ML_NN);
    const size_t tb = (size_t)b * SEQ;
    const int n_row = tid >> 3, n_pc = tid & 7;
    const int rp = lane & 31;
    const int kt_d0 = 8 * F.wave + 4 * hh;
    const int vt_v0 = 16 * F.wave + 8 * hh;
    const int e_t = tid >> 3, e_sub = tid & 7;
    f32x16 C[2] = {};
    float m2 = 0.f;
    __syncthreads();
    if (tid < 128) { NN[tid] = 0.f; ((LAS float*)(L + ML_GN))[tid] = mog[h * 128 + tid]; }
    pg8::u32x4 pq, pk, pv0, pv1, pmo0; u32x2 pkt0, pkt1; float pgi, pgf;
#define ML_PREFETCH(c) do { const size_t tc = tb + (size_t)(c) * 64; \
        pq = *(const pg8::u32x4*)(PROJ + (tc + n_row) * LDP + C_MQ + h * 64 + n_pc * 8); \
        pk = *(const pg8::u32x4*)(PROJ + (tc + n_row) * LDP + C_MK + h * 64 + n_pc * 8); \
        pkt0 = *(const u32x2*)(PROJ + (tc + 2 * rp) * LDP + C_MK + h * 64 + kt_d0); pkt1 = *(const u32x2*)(PROJ + (tc + 2 * rp + 1) * LDP + C_MK + h * 64 + kt_d0); \
        pv0 = *(const pg8::u32x4*)(PROJ + (tc + 2 * rp) * LDP + C_MV + h * 128 + vt_v0); pv1 = *(const pg8::u32x4*)(PROJ + (tc + 2 * rp + 1) * LDP + C_MV + h * 128 + vt_v0); \
        pgi = GATES[(tc + lane) * 16 + h]; pgf = GATES[(tc + lane) * 16 + 8 + h]; } while (0)
    ML_PREFETCH(0);
#pragma unroll 1
    for (int c = 0; c < 64; ++c) {
        const size_t tc = tb + (size_t)c * 64;
        const float i2 = pgi * LOG2E;
        float b2 = pgf * LOG2E;
        DPP_SCAN(b2, 0.f, DPP_ADD);
        const float a2 = i2 - b2;
        float pm = a2;
        DPP_SCAN(pm, -INFINITY, DPP_MAX);
        const float Mt2 = fmaxf(m2, pm);
        const float M63 = lane_bcast(Mt2, 63), b63 = lane_bcast(b2, 63);
        const float wint_l = __builtin_amdgcn_exp2f(m2 - Mt2), emt_l = __builtin_amdgcn_exp2f(-(b2 + Mt2));
        const float decay = __builtin_amdgcn_exp2f(m2 - M63);
        const float ws0 = __builtin_amdgcn_exp2f(__shfl(a2, 2 * rp) - M63), ws1 = __builtin_amdgcn_exp2f(__shfl(a2, 2 * rp + 1) - M63);
        const float Mt_t = __shfl(Mt2, 32 * ti + r), wint_t = __shfl(wint_l, 32 * ti + r), emt_t = __shfl(emt_l, 32 * ti + r);
        m2 = b63 + M63;
        if (F.wave == 0) AA[lane] = a2;
        *(LAS pg8::u32x4*)(L + ML_QS + n_row * ML_ROW + n_pc * 16) = pq;
        *(LAS pg8::u32x4*)(L + ML_KS + n_row * ML_ROW + n_pc * 16) = pk;
        {
            const float k0[4] = {pg8::bf_lo(pkt0.x), pg8::bf_hi(pkt0.x), pg8::bf_lo(pkt0.y), pg8::bf_hi(pkt0.y)}, k1[4] = {pg8::bf_lo(pkt1.x), pg8::bf_hi(pkt1.x), pg8::bf_lo(pkt1.y), pg8::bf_hi(pkt1.y)};
#pragma unroll
            for (int e = 0; e < 4; ++e) *(LAS unsigned*)(L + ML_KT + (kt_d0 + e) * ML_ROW + rp * 4) = pg8::cvt_pk_bf16(k0[e] * ws0, k1[e] * ws1);
            const unsigned w0[4] = {pv0.x, pv0.y, pv0.z, pv0.w}, w1[4] = {pv1.x, pv1.y, pv1.z, pv1.w};
#pragma unroll
            for (int e = 0; e < 4; ++e) {
                *(LAS unsigned*)(L + ML_VT + (vt_v0 + 2 * e) * ML_ROW + rp * 4) = (w0[e] & 0xffffu) | (w1[e] << 16);
                *(LAS unsigned*)(L + ML_VT + (vt_v0 + 2 * e + 1) * ML_ROW + rp * 4) = (w0[e] >> 16) | (w1[e] & 0xffff0000u);
            }
        }
        if (c > 0) { const size_t etc = tc - 64;
        {
            const LAS f32x4* hp = (const LAS f32x4*)(L + ML_HB + e_t * ML_HROW + e_sub * 64);
            float hv[16]; float ss = 0.f;
#pragma unroll
            for (int q4 = 0; q4 < 4; ++q4) { const f32x4 x4 = hp[q4];
#pragma unroll
                for (int e = 0; e < 4; ++e) { hv[4 * q4 + e] = x4[e]; ss += x4[e] * x4[e]; } }
            ss = sum8_dpp(ss, lane);
            const float rr = __builtin_amdgcn_rsqf(ss * (1.0f / 128.0f) + EPS);
            float mo[16]; { const unsigned w4[4] = {pmo0.x, pmo0.y, pmo0.z, pmo0.w};
#pragma unroll
                for (int q4 = 0; q4 < 4; ++q4)
#pragma unroll
                    for (int e = 0; e < 4; ++e) mo[4 * q4 + e] = (float)((w4[q4] >> (8 * e)) & 0xffu) * (1.0f / 255.0f); }
            float gain[16];
#pragma unroll
            for (int q4 = 0; q4 < 4; ++q4) { const f32x4 g4 = *(const LAS f32x4*)(L + ML_GN + (16 * e_sub + 4 * q4) * 4); gain[4 * q4] = g4[0]; gain[4 * q4 + 1] = g4[1]; gain[4 * q4 + 2] = g4[2]; gain[4 * q4 + 3] = g4[3]; }
            float o8[8];
#pragma unroll
            for (int e = 0; e < 8; ++e) o8[e] = hv[e] * rr * gain[e] * mo[e];
            bf16* dst = PROJ + (etc + e_t) * LDP + C_HMN + h * 128 + 16 * e_sub;
            *(pg8::u32x4*)(dst) = pg8::pack8(o8);
#pragma unroll
            for (int e = 0; e < 8; ++e) o8[e] = hv[8 + e] * rr * gain[8 + e] * mo[8 + e];
            *(pg8::u32x4*)(dst + 8) = pg8::pack8(o8);
        }
        }
        pmo0 = *(const pg8::u32x4*)((const unsigned char*)(PROJ + (tc + e_t) * LDP + C_MO) + h * 128 + 16 * e_sub);
        if (c + 1 < 64) ML_PREFETCH(c + 1);
        __syncthreads();
        const LAS float* ncur = NN + (c & 1) * 64; LAS float* nnxt = NN + ((c + 1) & 1) * 64;
        bf16x8 qf[4], kf[4], qb[2][2];
#pragma unroll
        for (int s4 = 0; s4 < 4; ++s4) qf[s4] = *(const LAS bf16x8*)(L + ML_QS + (32 * ti + r) * ML_ROW + s4 * 32 + hh * 16);
#pragma unroll
        for (int s4 = 0; s4 < 4; ++s4) kf[s4] = *(const LAS bf16x8*)(L + ML_KS + r * ML_ROW + s4 * 32 + hh * 16);
#pragma unroll
        for (int dt = 0; dt < 2; ++dt)
#pragma unroll
            for (int sp = 0; sp < 2; ++sp) {
                const LAS unsigned char* qp = L + ML_QS + (32 * ti + r) * ML_ROW + (32 * dt + 16 * sp + 4 * hh) * 2;
                const u32x2 lo = *(const LAS u32x2*)(qp), hi2 = *(const LAS u32x2*)(qp + 16);
                qb[dt][sp] = __builtin_bit_cast(bf16x8, (pg8::u32x4){lo.x, lo.y, hi2.x, hi2.y});
            }
        float nq = 0.f;
        {
            f32x4 nv[8];
#pragma unroll
            for (int s4 = 0; s4 < 4; ++s4) { nv[2 * s4] = *(const LAS f32x4*)(ncur + 16 * s4 + 8 * hh); nv[2 * s4 + 1] = *(const LAS f32x4*)(ncur + 16 * s4 + 8 * hh + 4); }
#pragma unroll
            for (int s4 = 0; s4 < 4; ++s4) {
                float q8[8]; pg8::unpack8(__builtin_bit_cast(pg8::u32x4, qf[s4]), q8);
#pragma unroll
                for (int e = 0; e < 4; ++e) nq += q8[e] * nv[2 * s4][e] + q8[4 + e] * nv[2 * s4 + 1][e];
            }
            nq += __shfl_xor(nq, 32);
        }
        bf16x8 ca[2][2];
#pragma unroll
        for (int dt = 0; dt < 2; ++dt)
#pragma unroll
            for (int sp = 0; sp < 2; ++sp) { float t8[8];
#pragma unroll
                for (int e = 0; e < 8; ++e) t8[e] = C[dt][8 * sp + e];
                ca[dt][sp] = __builtin_bit_cast(bf16x8, pg8::pack8(t8)); }
#pragma unroll
        for (int dt = 0; dt < 2; ++dt)
#pragma unroll
            for (int i = 0; i < 16; ++i) C[dt][i] *= decay;
        f32x16 num = {};
#pragma unroll
        for (int dt = 0; dt < 2; ++dt)
#pragma unroll
            for (int sp = 0; sp < 2; ++sp) num = __builtin_amdgcn_mfma_f32_32x32x16_bf16(ca[dt][sp], qb[dt][sp], num, 0, 0, 0);
        f32x16 P[2] = {};
#pragma unroll
        for (int s4 = 0; s4 < 4; ++s4) P[0] = __builtin_amdgcn_mfma_f32_32x32x16_bf16(kf[s4], qf[s4], P[0], 0, 0, 0);
        if (ti == 1) {
#pragma unroll
            for (int s4 = 0; s4 < 4; ++s4) kf[s4] = *(const LAS bf16x8*)(L + ML_KS + (32 + r) * ML_ROW + s4 * 32 + hh * 16);
#pragma unroll
            for (int s4 = 0; s4 < 4; ++s4) P[1] = __builtin_amdgcn_mfma_f32_32x32x16_bf16(kf[s4], qf[s4], P[1], 0, 0, 0);
        }
        bf16x8 vt[4];
#pragma unroll
        for (int s4 = 0; s4 < 4; ++s4) vt[s4] = *(const LAS bf16x8*)(L + ML_VT + (32 * vi + r) * ML_ROW + s4 * 32 + hh * 16);
#pragma unroll
        for (int dt = 0; dt < 2; ++dt) {
            bf16x8 kt[4];
#pragma unroll
            for (int s4 = 0; s4 < 4; ++s4) kt[s4] = *(const LAS bf16x8*)(L + ML_KT + (32 * dt + r) * ML_ROW + s4 * 32 + hh * 16);
#pragma unroll
            for (int s4 = 0; s4 < 4; ++s4) C[dt] = __builtin_amdgcn_mfma_f32_32x32x16_bf16(kt[s4], vt[s4], C[dt], 0, 0, 0);
        }
        f32x4 av[2][4];
#pragma unroll
        for (int st = 0; st < 2; ++st)
#pragma unroll
            for (int g = 0; g < 4; ++g) av[st][g] = *(const LAS f32x4*)(AA + 32 * (st <= ti ? st : 0) + 8 * g + 4 * hh);
        float dsum = 0.f;
        if (ti == 1) {
#pragma unroll
            for (int g = 0; g < 4; ++g)
#pragma unroll
                for (int e = 0; e < 4; ++e) { const float pvv = P[0][4 * g + e] * __builtin_amdgcn_exp2f(av[0][g][e] - Mt_t); P[0][4 * g + e] = pvv; dsum += pvv; }
        }
        {
            f32x16 D0 = ti == 1 ? P[1] : P[0];
#pragma unroll
            for (int g = 0; g < 4; ++g)
#pragma unroll
                for (int e = 0; e < 4; ++e) {
                    const float a = ti == 1 ? av[1][g][e] : av[0][g][e];
                    const float w = (8 * g + 4 * hh + e <= r) ? __builtin_amdgcn_exp2f(a - Mt_t) : 0.f;
                    const float pvv = D0[4 * g + e] * w; D0[4 * g + e] = pvv; dsum += pvv;
                }
            if (ti == 1) P[1] = D0; else P[0] = D0;
        }
        dsum += __shfl_xor(dsum, 32);
#pragma unroll
        for (int i = 0; i < 16; ++i) num[i] *= wint_t;
        bf16x8 va[2][2];
#pragma unroll
        for (int st = 0; st < 2; ++st)
#pragma unroll
            for (int sp = 0; sp < 2; ++sp) {
                const LAS unsigned char* vp = L + ML_VT + (32 * vi + r) * ML_ROW + (32 * (st <= ti ? st : 0) + 16 * sp + 4 * hh) * 2;
                const u32x2 lo = *(const LAS u32x2*)(vp), hi2 = *(const LAS u32x2*)(vp + 16);
                va[st][sp] = __builtin_bit_cast(bf16x8, (pg8::u32x4){lo.x, lo.y, hi2.x, hi2.y});
            }
#pragma unroll
        for (int st = 0; st < 2; ++st) {
            if (st <= ti) {
#pragma unroll
                for (int sp = 0; sp < 2; ++sp) {
                    float t8[8];
#pragma unroll
                    for (int e = 0; e < 8; ++e) t8[e] = P[st][8 * sp + e];
                    num = __builtin_amdgcn_mfma_f32_32x32x16_bf16(va[st][sp], __builtin_bit_cast(bf16x8, pg8::pack8(t8)), num, 0, 0, 0);
                }
            }
        }
        const float den = dsum + wint_t * nq;
        const float inv = __builtin_amdgcn_rcpf(fmaxf(fabsf(den), emt_t));
#pragma unroll
        for (int g = 0; g < 4; ++g) {
            const f32x4 hv = {num[4 * g] * inv, num[4 * g + 1] * inv, num[4 * g + 2] * inv, num[4 * g + 3] * inv};
            *(LAS f32x4*)(L + ML_HB + (32 * ti + r) * ML_HROW + (32 * vi + 8 * g + 4 * hh) * 4) = hv;
        }
        {
            const int d = tid >> 3, sub = tid & 7;
            float k8[8]; pg8::unpack8(*(const LAS pg8::u32x4*)(L + ML_KT + d * ML_ROW + sub * 16), k8);
            float s = ((k8[0] + k8[1]) + (k8[2] + k8[3])) + ((k8[4] + k8[5]) + (k8[6] + k8[7]));
            s = sum8_dpp(s, lane);
            if (sub == 0) nnxt[d] = decay * ncur[d] + s;
        }
        __syncthreads();
    }
    __syncthreads();
    { const size_t etc = tb + 63 * 64;
        {
            const LAS f32x4* hp = (const LAS f32x4*)(L + ML_HB + e_t * ML_HROW + e_sub * 64);
            float hv[16]; float ss = 0.f;
#pragma unroll
            for (int q4 = 0; q4 < 4; ++q4) { const f32x4 x4 = hp[q4];
#pragma unroll
                for (int e = 0; e < 4; ++e) { hv[4 * q4 + e] = x4[e]; ss += x4[e] * x4[e]; } }
            ss = sum8_dpp(ss, lane);
            const float rr = __builtin_amdgcn_rsqf(ss * (1.0f / 128.0f) + EPS);
            float mo[16]; { const unsigned w4[4] = {pmo0.x, pmo0.y, pmo0.z, pmo0.w};
#pragma unroll
                for (int q4 = 0; q4 < 4; ++q4)
#pragma unroll
                    for (int e = 0; e < 4; ++e) mo[4 * q4 + e] = (float)((w4[q4] >> (8 * e)) & 0xffu) * (1.0f / 255.0f); }
            float gain[16];
#pragma unroll
            for (int q4 = 0; q4 < 4; ++q4) { const f32x4 g4 = *(const LAS f32x4*)(L + ML_GN + (16 * e_sub + 4 * q4) * 4); gain[4 * q4] = g4[0]; gain[4 * q4 + 1] = g4[1]; gain[4 * q4 + 2] = g4[2]; gain[4 * q4 + 3] = g4[3]; }
            float o8[8];
#pragma unroll
            for (int e = 0; e < 8; ++e) o8[e] = hv[e] * rr * gain[e] * mo[e];
            bf16* dst = PROJ + (etc + e_t) * LDP + C_HMN + h * 128 + 16 * e_sub;
            *(pg8::u32x4*)(dst) = pg8::pack8(o8);
#pragma unroll
            for (int e = 0; e < 8; ++e) o8[e] = hv[8 + e] * rr * gain[8 + e] * mo[8 + e];
            *(pg8::u32x4*)(dst + 8) = pg8::pack8(o8);
        }
    }
#undef ML_PREFETCH
}

typedef __bf16 bf16x2_t __attribute__((ext_vector_type(2)));
__device__ __forceinline__ float dot2bf(unsigned a, unsigned b, float c) { return __builtin_amdgcn_fdot2_f32_bf16(__builtin_bit_cast(bf16x2_t, a), __builtin_bit_cast(bf16x2_t, b), c, false); }
__device__ __forceinline__ float dot8(const pg8::u32x4 a, const pg8::u32x4 b, float c) { c = dot2bf(a.x, b.x, c); c = dot2bf(a.y, b.y, c); c = dot2bf(a.z, b.z, c); return dot2bf(a.w, b.w, c); }
__device__ __forceinline__ float gelu_erf(float v) {
    const float av = fabsf(v), t = __builtin_amdgcn_rcpf(av * 0.2316418882f + 1.0f);
    float q = t * 0.5307027145f + (-0.7265760135f); q = q * t + 0.7107068705f; q = q * t + (-0.142248368f); q = q * t + 0.127414796f; q = q * t;
    const float e = __builtin_amdgcn_exp2f((v * v) * (-0.72134752044f));
    const float m = v * (q * e);
    return v < 0.f ? m : v - m;
}

__device__ __forceinline__ int f2ord(float x) { const int u = __builtin_bit_cast(int, x); return u ^ ((u >> 31) & 0x7FFFFFFF); }
__device__ __forceinline__ float ord2f(int k) { return __builtin_bit_cast(float, k ^ ((k >> 31) & 0x7FFFFFFF)); }
#define RT_CE(a, b) do { const int _hi = max((a), (b)), _lo = min((a), (b)); (a) = _hi; (b) = _lo; } while (0)
__device__ __forceinline__ void sort16_desc(int (&v)[16]) {
#pragma unroll
    for (int k = 2; k <= 16; k <<= 1)
#pragma unroll
        for (int j = k >> 1; j > 0; j >>= 1)
#pragma unroll
            for (int i = 0; i < 16; ++i) { const int l = i ^ j; if (l > i) { if ((i & k) == 0) RT_CE(v[i], v[l]); else RT_CE(v[l], v[i]); } }
}
__device__ __forceinline__ void merge16_desc(int (&a)[16], const int (&b)[16]) {
#pragma unroll
    for (int i = 0; i < 16; ++i) a[i] = max(a[i], b[15 - i]);
#pragma unroll
    for (int j = 8; j > 0; j >>= 1)
#pragma unroll
        for (int i = 0; i < 16; ++i) { const int l = i ^ j; if (l > i) RT_CE(a[i], a[l]); }
}
constexpr int RT_LROW = 33;
struct RouteQ { bf16x8 q[2][4]; };
__device__ __forceinline__ void route_load_q(RouteQ& Q, const bf16* __restrict__ PROJ, int tt, int h, int lane) {
    const int r = lane & 31, hh = lane >> 5;
    const bf16* qrow = PROJ + ((size_t)tt * 32 + r) * LDP + C_QB + h * 128 + 8 * hh;
#pragma unroll
    for (int p = 0; p < 2; ++p)
#pragma unroll
        for (int s = 0; s < 4; ++s) Q.q[p][s] = *(const bf16x8*)(qrow + p * 64 + 16 * s);
}
constexpr int RT_KEYS_OFF = 8 * 64 * RT_LROW * 4, RT_KROW = 144;
__device__ __forceinline__ void route_unit(Frame& F, const RouteQ& Q, int* __restrict__ IDX, float* __restrict__ GATE, int tt, int h) {
    const int lane = (int)__builtin_amdgcn_mbcnt_hi(~0u, __builtin_amdgcn_mbcnt_lo(~0u, 0u)), r = lane & 31, hh = lane >> 5;
    const size_t tok = (size_t)tt * 32 + r;
    LAS int* my = (LAS int*)(F.lds + F.wave * (64 * RT_LROW * 4)) + lane * RT_LROW;
    int top[2][16];
#pragma unroll
    for (int p = 0; p < 2; ++p) {
        bf16x8 qf[4];
#pragma unroll
        for (int s = 0; s < 4; ++s) qf[s] = Q.q[p][s];
        const LAS unsigned char* kb = F.lds + RT_KEYS_OFF + (p * 128 + r) * RT_KROW + 16 * hh;
        int run[16];
#pragma unroll
        for (int kt = 0; kt < 4; ++kt) {
            f32x16 acc = {};
#pragma unroll
            for (int s = 0; s < 4; ++s) acc = __builtin_amdgcn_mfma_f32_32x32x16_bf16(*(const LAS bf16x8*)(kb + kt * 32 * RT_KROW + 32 * s), qf[s], acc, 0, 0, 0);
            int g[16];
            int hh4 = 4 * hh; asm volatile("" : "+v"(hh4));
#pragma unroll
            for (int i = 0; i < 16; ++i) { const int k0 = 127 - (32 * kt + (i & 3) + 8 * (i >> 2)); g[i] = ((f2ord(acc[i]) & ~0x7F) | k0) ^ hh4; }
            sort16_desc(g);
            if (kt == 0) {
#pragma unroll
                for (int i = 0; i < 16; ++i) run[i] = g[i];
            } else merge16_desc(run, g);
            __builtin_amdgcn_sched_barrier(0);
        }
        {
            int other[16];
#pragma unroll
            for (int i = 0; i < 16; ++i) other[i] = __shfl_xor(run[i], 32);
            merge16_desc(run, other);
        }
#pragma unroll
        for (int i = 0; i < 16; ++i) { top[p][i] = run[i]; my[p * 16 + i] = 127 - (run[i] & 0x7F); }
        asm volatile("" ::: "memory"); __builtin_amdgcn_sched_barrier(0);
    }
    int c[4][16];
    {
        float fa[16], fb[16];
#pragma unroll
        for (int i = 0; i < 16; ++i) { fa[i] = ord2f(top[0][i] & ~0x7F); fb[i] = ord2f(top[1][i] & ~0x7F); }
#define RT_CAND(i, j) ((f2ord(fa[i] + fb[j]) & ~0xFF) | (255 - ((i) * 16 + (j))))
#pragma unroll
        for (int j = 0; j < 16; ++j) c[0][j] = RT_CAND(0, j);
#pragma unroll
        for (int j = 0; j < 8; ++j) { c[1][j] = RT_CAND(1, j); c[1][8 + j] = RT_CAND(15 - j, 0); }
        c[2][0] = RT_CAND(2, 0); c[2][1] = RT_CAND(2, 1); c[2][2] = RT_CAND(2, 2); c[2][3] = RT_CAND(2, 3); c[2][4] = RT_CAND(2, 4);
        c[2][5] = RT_CAND(3, 0); c[2][6] = RT_CAND(3, 1); c[2][7] = RT_CAND(3, 2); c[2][8] = RT_CAND(3, 3);
        c[2][9] = RT_CAND(4, 0); c[2][10] = RT_CAND(4, 1); c[2][11] = RT_CAND(4, 2);
        c[2][12] = RT_CAND(5, 0); c[2][13] = RT_CAND(5, 1); c[2][14] = RT_CAND(6, 0); c[2][15] = RT_CAND(6, 1);
        c[3][0] = RT_CAND(7, 0); c[3][1] = RT_CAND(7, 1);
#pragma unroll
        for (int j = 2; j < 16; ++j) c[3][j] = (int)0x80000000;
#undef RT_CAND
    }
#pragma unroll
    for (int j = 8; j > 0; j >>= 1)
#pragma unroll
        for (int i = 0; i < 16; ++i) { const int l = i ^ j; if (l > i) RT_CE(c[1][i], c[1][l]); }
    __builtin_amdgcn_sched_barrier(0);
    sort16_desc(c[2]); __builtin_amdgcn_sched_barrier(0);
    merge16_desc(c[0], c[1]); __builtin_amdgcn_sched_barrier(0); merge16_desc(c[2], c[3]); __builtin_amdgcn_sched_barrier(0); merge16_desc(c[0], c[2]); __builtin_amdgcn_sched_barrier(0);
    float ev[16]; float sum = 0.f; const float v0 = ord2f(c[0][0] & ~0xFF);
#pragma unroll
    for (int k = 0; k < 16; ++k) { ev[k] = __expf(ord2f(c[0][k] & ~0xFF) - v0); sum += ev[k]; }
    const float inv = __builtin_amdgcn_rcpf(sum);
    asm volatile("s_waitcnt lgkmcnt(0)" ::: "memory");
    int oi[8]; float og[8];
#pragma unroll
    for (int k = 0; k < 8; ++k) {
        const int cc = hh ? c[0][8 + k] : c[0][k]; const float e = hh ? ev[8 + k] : ev[k];
        const int pos = 255 - (cc & 0xFF);
        oi[k] = my[pos >> 4] * 128 + my[16 + (pos & 15)]; og[k] = e * inv;
    }
    unsigned* ip = (unsigned*)IDX + tok * 128 + 2 * h + hh;
#pragma unroll
    for (int k = 0; k < 8; ++k) ip[16 * k] = (unsigned)oi[k] | (f2bf(og[k]) << 16);
}

constexpr int C_XQ = 3072;
struct QRow { pg8::u32x4 v[2]; float sq; };
__device__ __forceinline__ QRow quantize_load(const bf16* __restrict__ PROJ, const float* __restrict__ SSQ, int t, int lane) {
    const pg8::u32x4* xr = (const pg8::u32x4*)(PROJ + (size_t)t * LDP + C_X1B + 16 * lane); QRow q;
    q.v[0] = xr[0]; q.v[1] = xr[1];
    q.sq = SSQ[(size_t)t * 16 + (lane & 15)]; return q;
}
__device__ __forceinline__ void quantize_row(const QRow& q, bf16* __restrict__ PROJ, float* __restrict__ XDQ, int t, int lane) {
    float xv[16];
#pragma unroll
    for (int j = 0; j < 2; ++j) { float t8[8]; pg8::unpack8(q.v[j], t8);
#pragma unroll
        for (int k = 0; k < 8; ++k) xv[8 * j + k] = t8[k]; }
    float am = 0.f;
#pragma unroll
    for (int k = 0; k < 16; ++k) am = fmaxf(am, fabsf(xv[k]));
    am = fmaxf(wave_max(am), 1e-30f);
    const float isx = 127.0f / am;
    unsigned xq[4];
#pragma unroll
    for (int qq = 0; qq < 4; ++qq) { unsigned a4 = 0u;
#pragma unroll
        for (int k = 0; k < 4; ++k) a4 |= (unsigned)((int)__builtin_rintf(xv[4 * qq + k] * isx) & 0xff) << (8 * k);
        xq[qq] = a4; }
    *(pg8::u32x4*)((unsigned char*)(PROJ + (size_t)t * LDP + C_XQ) + 16 * lane) = (pg8::u32x4){xq[0], xq[1], xq[2], xq[3]};
    float tot = q.sq; tot += __shfl_xor(tot, 1); tot += __shfl_xor(tot, 2); tot += __shfl_xor(tot, 4); tot += __shfl_xor(tot, 8);
    if (lane == 0) XDQ[t] = __builtin_amdgcn_rsqf(tot * (1.0f / 1024.0f) + EPS) * am * (1.0f / 127.0f);
}
constexpr int DN_TOK_BYTES = 512 + 1024 + 16, DN_BATCH = 8, DN_MERGE = 4, DN_WAVE_BYTES = DN_BATCH * DN_TOK_BYTES + DN_MERGE * 256;
__device__ __forceinline__ void down_rows(pg8::u32x4 (&R)[8], pg8::u32x4 (&X)[8], const LAS unsigned short* LP, const LAS unsigned char* st0, int g, int n, int lane, const unsigned char* __restrict__ DOWNP) {
    const int j = 8 * g + (lane >> 3);
    const unsigned idx = LP[j < n ? j : 0];
    const LAS unsigned char* sp = st0 + (idx >> 7) * DN_TOK_BYTES;
    const unsigned w = *(const LAS unsigned*)(sp + (idx & 127u) * 4u);
    const unsigned char* rp = DOWNP + ((w & 0x7ffu) << 10) + 16u * (unsigned)(lane & 7);
#pragma unroll
    for (int c = 0; c < 8; ++c) R[c] = *(const pg8::u32x4*)(rp + 128 * c);
    const LAS unsigned char* xs = sp + 512 + 16 * (lane & 7);
#pragma unroll
    for (int c = 0; c < 8; ++c) X[c] = *(const LAS pg8::u32x4*)(xs + 128 * c);
}
__device__ __forceinline__ int down_dot(const pg8::u32x4 (&R)[8], const pg8::u32x4 (&xq)[8]) {
    int a = 0;
#pragma unroll
    for (int c = 0; c < 8; ++c) { a = __builtin_amdgcn_sdot4((int)xq[c].x, (int)R[c].x, a, false); a = __builtin_amdgcn_sdot4((int)xq[c].y, (int)R[c].y, a, false); a = __builtin_amdgcn_sdot4((int)xq[c].z, (int)R[c].z, a, false); a = __builtin_amdgcn_sdot4((int)xq[c].w, (int)R[c].w, a, false); }
    a += __builtin_amdgcn_update_dpp(0, a, 0xB1, 0xf, 0xf, true);
    a += __builtin_amdgcn_update_dpp(0, a, 0x4E, 0xf, 0xf, true);
    const int up4 = __builtin_amdgcn_update_dpp(0, a, 0x104, 0xf, 0xf, true), dn4 = __builtin_amdgcn_update_dpp(0, a, 0x114, 0xf, 0xf, true);
    return a + ((__builtin_amdgcn_mbcnt_hi(~0u, __builtin_amdgcn_mbcnt_lo(~0u, 0u)) & 4u) ? dn4 : up4);
}
__device__ __forceinline__ void down_finish(int mine, const LAS unsigned short* LP, const LAS unsigned char* st0, const LAS float* LSD, const LAS float* LSU, int gbase, int n, int t0, int nw, int lane, unsigned* __restrict__ IC) {
    const int j = 8 * (gbase + (lane & 7)) + (lane >> 3);
    if (j < n) {
        const unsigned idx = LP[j], tok = idx >> 7, pos = idx & 127u;
        const LAS unsigned char* sp = st0 + tok * DN_TOK_BYTES;
        const unsigned w = *(const LAS unsigned*)(sp + pos * 4u), row = w & 0xffffu;
        const float gate = __builtin_bit_cast(float, w & 0xffff0000u), sd = LSD[row & 0x7ffu], su = LSU[row & 0x7ffu], dq = *(const LAS float*)(sp + 1536);
        const float s = (float)mine * dq * sd;
        IC[(size_t)(t0 + (int)tok * nw) * 128 + pos] = row | (f2bf(gate * su * gelu_erf(s)) << 16);
    }
}
__device__ __forceinline__ void down_process(const LAS unsigned char* st0, int t0, int nw, int ntok, int p, int lane, LAS unsigned short* LP, const LAS float* LSD, const LAS float* LSU, const unsigned char* __restrict__ DOWNP, unsigned* __restrict__ IC) {
    int n = 0;
#pragma unroll
    for (int k = 0; k < DN_MERGE; ++k) {
        const LAS unsigned* sk = (const LAS unsigned*)(st0 + k * DN_TOK_BYTES);
        const unsigned a0 = sk[lane], a1 = sk[64 + lane];
        const bool s0 = k < ntok && (int)((a0 & 0xffffu) >> 11) == p, s1 = k < ntok && (int)((a1 & 0xffffu) >> 11) == p;
        const unsigned long long m0 = __ballot(s0), m1 = __ballot(s1);
        const int c0 = __builtin_popcountll(m0);
        const int r0 = n + (int)__builtin_amdgcn_mbcnt_hi((unsigned)(m0 >> 32), __builtin_amdgcn_mbcnt_lo((unsigned)m0, 0u));
        const int r1 = n + c0 + (int)__builtin_amdgcn_mbcnt_hi((unsigned)(m1 >> 32), __builtin_amdgcn_mbcnt_lo((unsigned)m1, 0u));
        if (s0) LP[r0] = (unsigned short)(k * 128 + lane);
        if (s1) LP[r1] = (unsigned short)(k * 128 + 64 + lane);
        n += c0 + __builtin_popcountll(m1);
    }
    if (n == 0) return;
    asm volatile("s_waitcnt lgkmcnt(0)" ::: "memory");
    const int ng = (n + 7) >> 3, pc = lane & 7;
    pg8::u32x4 Ra[8], Rb[8], Xa[8], Xb[8];
    down_rows(Ra, Xa, LP, st0, 0, n, lane, DOWNP);
    int mine = 0;
#pragma unroll 1
    for (int g = 0; g < ng; g += 2) {
        if (g + 1 < ng) down_rows(Rb, Xb, LP, st0, g + 1, n, lane, DOWNP);
        { const int a = down_dot(Ra, Xa); mine = ((g & 7) == pc) ? a : mine; }
        if (g + 1 < ng) {
            if (g + 2 < ng) down_rows(Ra, Xa, LP, st0, g + 2, n, lane, DOWNP);
            const int a = down_dot(Rb, Xb); mine = (((g + 1) & 7) == pc) ? a : mine;
        }
        if ((g & 7) == 6 || g + 2 >= ng) down_finish(mine, LP, st0, LSD, LSU, g & ~7, n, t0, nw, lane, IC);
    }
    asm volatile("s_waitcnt lgkmcnt(0)" ::: "memory");
}
__device__ __forceinline__ void peer_down_phase(Frame& F, const bf16* __restrict__ PROJ, const float* __restrict__ XDQ, const unsigned* __restrict__ IG, unsigned* __restrict__ IC, const unsigned char* __restrict__ DOWN,
                                                const float* __restrict__ SCD, const float* __restrict__ SCU, int p, int w0, int nw) {
    LAS float* LSD = (LAS float*)(F.lds); LAS float* LSU = LSD + 2048;
    LAS unsigned char* wb = F.lds + 16384 + F.wave * DN_WAVE_BYTES;
    LAS unsigned short* LP = (LAS unsigned short*)(wb + DN_BATCH * DN_TOK_BYTES);
    const int lane = F.lane;
    __syncthreads();
    { int t0 = (int)threadIdx.x; asm volatile("" : "+v"(t0));
      for (int i = t0; i < 2048; i += NTHREADS) { LSD[i] = SCD[2048 * p + i]; LSU[i] = SCU[2048 * p + i]; } }
    __syncthreads();
    const unsigned char* DOWNP = DOWN + (size_t)p * 2048 * D;
    const int NT = (M - w0 + nw - 1) / nw;
#pragma unroll 1
    for (int i0 = 0; i0 < NT; i0 += DN_BATCH) {
        const int nb = (NT - i0) < DN_BATCH ? (NT - i0) : DN_BATCH;
        unsigned g0[DN_BATCH], g1[DN_BATCH]; pg8::u32x4 xr[DN_BATCH]; float dqv[DN_BATCH];
#pragma unroll
        for (int k = 0; k < DN_BATCH; ++k) {
            const int t = w0 + (i0 + (k < nb ? k : nb - 1)) * nw;
            g0[k] = __builtin_nontemporal_load(IG + (size_t)t * 128 + lane); g1[k] = __builtin_nontemporal_load(IG + (size_t)t * 128 + 64 + lane);
            xr[k] = __builtin_nontemporal_load((const pg8::u32x4*)((const unsigned char*)(PROJ + (size_t)t * LDP + C_XQ) + 16 * lane));
            dqv[k] = XDQ[t];
        }
#pragma unroll
        for (int k = 0; k < DN_BATCH; ++k) {
            LAS unsigned char* st = wb + k * DN_TOK_BYTES;
            ((LAS unsigned*)st)[lane] = g0[k]; ((LAS unsigned*)st)[64 + lane] = g1[k];
            *(LAS pg8::u32x4*)(st + 512 + 16 * lane) = xr[k];
            if (lane == 0) *(LAS float*)(st + 1536) = dqv[k];
        }
        asm volatile("s_waitcnt vmcnt(0) lgkmcnt(0)" ::: "memory");
#pragma unroll 1
        for (int k = 0; k < nb; k += DN_MERGE) down_process(wb + k * DN_TOK_BYTES, w0 + (i0 + k) * nw, nw, (nb - k) < DN_MERGE ? (nb - k) : DN_MERGE, p, lane, LP, LSD, LSU, DOWNP, IC);
    }
}
__device__ __forceinline__ void up_read_ic(unsigned (&ic)[16], const LAS unsigned char* st, int es) {
#pragma unroll
    for (int q = 0; q < 4; ++q) { const pg8::u32x4 iv = *(const LAS pg8::u32x4*)(st + es * 64 + 16 * q); ic[4 * q] = iv.x; ic[4 * q + 1] = iv.y; ic[4 * q + 2] = iv.z; ic[4 * q + 3] = iv.w; }
}
__device__ __forceinline__ void up_issue_rows(pg8::u32x4 (&R)[16], const unsigned (&ic)[16], const unsigned char* __restrict__ ub, unsigned pcoff) {
#pragma unroll
    for (int i = 0; i < 16; ++i) R[i] = *(const pg8::u32x4*)(ub + (((ic[i] & 0xffffu) << 7) | pcoff));
}
typedef float f32x2 __attribute__((ext_vector_type(2)));
__device__ __forceinline__ void up_compute(const pg8::u32x4 (&R)[16], const unsigned (&ic)[16], const f32x2 x1, f32x2* optr, bool store, int lane) {
    f32x2 acc2[8]; float csum = 0.f;
#pragma unroll
    for (int k = 0; k < 8; ++k) acc2[k] = (f32x2){0.f, 0.f};
#pragma unroll
    for (int i = 0; i < 16; ++i) {
        const float c = __builtin_bit_cast(float, ic[i] & 0xffff0000u); csum += c;
        const f32x2 cc = {c, c};
        const unsigned w4[4] = {R[i].x, R[i].y, R[i].z, R[i].w};
#pragma unroll
        for (int q = 0; q < 4; ++q) {
            const f32x2 lo = {(float)(w4[q] & 0xffu), (float)((w4[q] >> 8) & 0xffu)}, hi = {(float)((w4[q] >> 16) & 0xffu), (float)(w4[q] >> 24)};
            acc2[2 * q] = __builtin_elementwise_fma(cc, lo, acc2[2 * q]); acc2[2 * q + 1] = __builtin_elementwise_fma(cc, hi, acc2[2 * q + 1]);
        }
    }
    float acc[16];
#pragma unroll
    for (int k = 0; k < 8; ++k) { acc[2 * k] = acc2[k].x; acc[2 * k + 1] = acc2[k].y; }
    csum += __shfl_xor(csum, 8); csum += __shfl_xor(csum, 16); csum += __shfl_xor(csum, 32);
#pragma unroll
    for (int k = 0; k < 8; ++k) { const bool up = (lane & 32) != 0; const float send = up ? acc[k] : acc[k + 8], keep = up ? acc[k + 8] : acc[k]; acc[k] = keep + __shfl_xor(send, 32); }
#pragma unroll
    for (int k = 0; k < 4; ++k) { const bool up = (lane & 16) != 0; const float send = up ? acc[k] : acc[k + 4], keep = up ? acc[k + 4] : acc[k]; acc[k] = keep + __shfl_xor(send, 16); }
#pragma unroll
    for (int k = 0; k < 2; ++k) { const bool up = (lane & 8) != 0; const float send = up ? acc[k] : acc[k + 2], keep = up ? acc[k + 2] : acc[k]; acc[k] = keep + __shfl_xor(send, 8); }
    const float off = 128.0f * csum;
    if (store) __builtin_nontemporal_store((f32x2){x1[0] + acc[0] - off, x1[1] + acc[1] - off}, optr);
}
__device__ __forceinline__ void up_compute_reload(pg8::u32x4 (&R)[16], const unsigned (&ic)[16], const unsigned (&icn)[16], const unsigned char* __restrict__ ub, unsigned pcoff, const f32x2 x1, f32x2* optr, int lane) {
    f32x2 acc2[8];
#pragma unroll
    for (int k = 0; k < 8; ++k) acc2[k] = (f32x2){0.f, 0.f};
#pragma unroll
    for (int i = 0; i < 16; ++i) {
        const float c = __builtin_bit_cast(float, ic[i] & 0xffff0000u);
        const f32x2 cc = {c, c};
        const unsigned w4[4] = {R[i].x, R[i].y, R[i].z, R[i].w};
#pragma unroll
        for (int q = 0; q < 4; ++q) {
            const f32x2 lo = __builtin_amdgcn_cvt_pk_f32_fp8((int)w4[q], false), hi = __builtin_amdgcn_cvt_pk_f32_fp8((int)w4[q], true);
            acc2[2 * q] = __builtin_elementwise_fma(cc, lo, acc2[2 * q]); acc2[2 * q + 1] = __builtin_elementwise_fma(cc, hi, acc2[2 * q + 1]);
        }
        __builtin_amdgcn_sched_barrier(0);
        __builtin_amdgcn_s_setprio(2);
        R[i] = *(const pg8::u32x4*)(ub + (((icn[i] & 0xffffu) << 7) | pcoff));
        __builtin_amdgcn_s_setprio(0);
        __builtin_amdgcn_sched_barrier(0);
    }
    float acc[16];
#pragma unroll
    for (int k = 0; k < 8; ++k) { acc[2 * k] = acc2[k].x; acc[2 * k + 1] = acc2[k].y; }
#pragma unroll
    for (int k = 0; k < 8; ++k) { const bool up = (lane & 32) != 0; const float send = up ? acc[k] : acc[k + 8], keep = up ? acc[k + 8] : acc[k]; acc[k] = keep + __shfl_xor(send, 32); }
#pragma unroll
    for (int k = 0; k < 4; ++k) { const bool up = (lane & 16) != 0; const float send = up ? acc[k] : acc[k + 4], keep = up ? acc[k + 4] : acc[k]; acc[k] = keep + __shfl_xor(send, 16); }
#pragma unroll
    for (int k = 0; k < 2; ++k) { const bool up = (lane & 8) != 0; const float send = up ? acc[k] : acc[k + 2], keep = up ? acc[k + 2] : acc[k]; acc[k] = keep + __builtin_bit_cast(float, __builtin_amdgcn_update_dpp(0, __builtin_bit_cast(int, send), 0x128, 0xf, 0xf, true)); }
    __builtin_nontemporal_store((f32x2){x1[0] + acc[0], x1[1] + acc[1]}, optr);
}
constexpr int UP_TOK_BYTES = 512 + 512, UP_BATCH = 8, UP_WAVE_BYTES = UP_BATCH * UP_TOK_BYTES;
__device__ __forceinline__ void peer_up_phase(Frame& F, const unsigned* __restrict__ IC, const unsigned char* __restrict__ UP, const bf16* __restrict__ PROJ, float* out, int p, int w0, int nw) {
    const int lane = F.lane, es = lane >> 3, pc = lane & 7;
    const int slot = ((lane >> 5) & 1) * 4 + ((lane >> 4) & 1) * 2 + ((lane >> 3) & 1);
    const unsigned char* ub = UP + (size_t)p * ((size_t)NEXP * 128); const unsigned pcoff = 16u * (unsigned)pc;
    float* ob = out + 128 * p + 16 * pc + 2 * slot;
    const bf16* xb = PROJ + C_X1B + 128 * p + 16 * pc + 2 * slot;
    LAS unsigned char* wb = F.lds + F.wave * (2 * UP_WAVE_BYTES);
    const int NT = (M - w0 + nw - 1) / nw;
    unsigned pg0[2], pg1[2], pxw[2];
#define UP_SLOT(I) (wb + ((I) & 15) * UP_TOK_BYTES)
#define UP_LOAD2(I) do { _Pragma("unroll") for (int q_ = 0; q_ < 2; ++q_) { const int i_ = (I) + q_; const int t_ = w0 + (i_ < NT ? i_ : NT - 1) * nw; \
        pg0[q_] = __builtin_nontemporal_load(IC + (size_t)t_ * 128 + lane); pg1[q_] = __builtin_nontemporal_load(IC + (size_t)t_ * 128 + 64 + lane); \
        pxw[q_] = __builtin_nontemporal_load((const unsigned*)(xb + (size_t)t_ * LDP)); } } while (0)
#define UP_STORE2(I) do { _Pragma("unroll") for (int q_ = 0; q_ < 2; ++q_) { LAS unsigned char* st_ = UP_SLOT((I) + q_); \
        ((LAS unsigned*)st_)[lane] = pg0[q_]; ((LAS unsigned*)st_)[64 + lane] = pg1[q_]; ((LAS unsigned*)(st_ + 512))[lane] = pxw[q_]; } } while (0)
#define UP_X1(I) ({ const unsigned w_ = ((const LAS unsigned*)(UP_SLOT(I) + 512))[lane]; (f32x2){pg8::bf_lo(w_), pg8::bf_hi(w_)}; })
    UP_LOAD2(0); UP_STORE2(0); UP_LOAD2(2); UP_STORE2(2); UP_LOAD2(4); UP_STORE2(4); UP_LOAD2(6);
    asm volatile("s_waitcnt lgkmcnt(0)" ::: "memory");
    unsigned ica[16], icb[16], icn[16]; pg8::u32x4 R0[16], R1[16];
    up_read_ic(ica, UP_SLOT(0), es); up_issue_rows(R0, ica, ub, pcoff);
    up_read_ic(icb, UP_SLOT(1), es); up_issue_rows(R1, icb, ub, pcoff);
#pragma unroll 1
    for (int k = 0; k < NT; k += 2) {
        UP_STORE2(k + 6); UP_LOAD2(k + 8);
        up_read_ic(icn, UP_SLOT(k + 2), es);
        up_compute_reload(R0, ica, icn, ub, pcoff, UP_X1(k), (f32x2*)(ob + (size_t)(w0 + k * nw) * D), lane);
#pragma unroll
        for (int i = 0; i < 16; ++i) ica[i] = icn[i];
        if (k + 1 < NT) {
            up_read_ic(icn, UP_SLOT(k + 3), es);
            up_compute_reload(R1, icb, icn, ub, pcoff, UP_X1(k + 1), (f32x2*)(ob + (size_t)(w0 + (k + 1) * nw) * D), lane);
#pragma unroll
            for (int i = 0; i < 16; ++i) icb[i] = icn[i];
        }
    }
    asm volatile("s_waitcnt vmcnt(0)" ::: "memory");
    asm volatile("s_waitcnt lgkmcnt(0)" ::: "memory");
#undef UP_SLOT
#undef UP_LOAD2
#undef UP_STORE2
#undef UP_X1
}

constexpr int NPHASE = 9;
#ifndef STAGGER_TICKS
#define STAGGER_TICKS 700
#endif
#ifndef PROBE_REPS
#define PROBE_REPS {1, 1, 1, 1, 1, 1, 1, 1, 1}
#endif
constexpr int probe_rep[NPHASE] = PROBE_REPS;
__global__ void __launch_bounds__(NTHREADS, 2) mega(Args args) {
    extern __shared__ __attribute__((aligned(16))) unsigned char lds[];
    Frame F;
    F.lds = (LAS unsigned char*)lds;
    F.MISC = (volatile LAS unsigned*)(F.lds + MISC_OFF);
    F.tid = threadIdx.x; F.lane = F.tid & 63; F.wave = __builtin_amdgcn_readfirstlane(F.tid >> 6);
    F.G = gridDim.x;
    unsigned char* ws = args.ws;
    F.ctl = (gu32*)(ws + WS_CTL);
    for (int u = F.tid; u < (LDS_BYTES - LDSCTL_OFF) / 4; u += NTHREADS) ((LAS unsigned*)(F.lds + LDSCTL_OFF))[u] = 0u;
    __syncthreads();
    XcdBarrier bar = xcd_barrier_post((unsigned*)(F.ctl + CW_BAR), F.MISC + 8);
    if (F.tid == 0) F.MISC[1] = __hip_atomic_fetch_add(F.ctl + CW_XRANK + 64 * bar.x, 1u, RLX_AGENT);
    const int lo = args.ph_lo, hi = args.ph_hi;
#define IN(k) (lo <= (k) && (k) < hi)
#define BOTH(k) (IN(k) && IN((k) + 1))
    bf16* PROJ = (bf16*)(ws + WS_PROJ);
    bf16* XN = (bf16*)args.out; bf16* T1 = (bf16*)args.out;

    if (IN(0)) for (int rep = 0; rep < probe_rep[0]; ++rep) { p0_prologue(F, args, 0); xcd_barrier(bar); p0_prologue(F, args, 1); if (BOTH(0)) xcd_barrier(bar); }
    if (IN(1)) for (int rep = 0; rep < probe_rep[1]; ++rep) {
        pg8::Gemm g{(const bf16*)args.out, (const bf16*)(ws + WS_W1T), M, NP, D / 2, D / 2, nullptr, 0, D / 2}; pg8::StaticOrder S; S.init(M, NP, F.G, (int)blockIdx.x);
        pg8::EpiProj E{PROJ, (const float*)(ws + WS_SSQ), (const float*)(F.ctl + CW_SWMAX), (unsigned char*)(PROJ + (size_t)M * LDP), F.lds + MISC_OFF + 1024};
        pg8::gemm_phase_i8<pg8::EpiProj, pg8::StaticOrder, true, true>(F.lds + RING_OFF, g, S, E);
        if (BOTH(1)) xcd_barrier(bar);
    }
    if (IN(2)) {
        gu32* qhead = F.ctl + CW_QUEUE;
        for (;;) {
            __syncthreads();
            if (F.tid == 0) F.MISC[0] = __hip_atomic_fetch_add(qhead, 1u, RLX_AGENT);
            __syncthreads();
            const unsigned u = F.MISC[0];
            if (u >= 128u + 1024u) break;
            if (u < 128u) mlstm_unit(F, PROJ, (const float*)(ws + WS_GATES), (const float*)args.in[9], (int)u);
            else attn_unit(F, (bf16*)args.out, PROJ, (const float*)(ws + WS_ROPE), (const float*)args.in[6], (const float*)args.in[7], (const float*)args.in[8], (int)u - 128);
        }
        for (;;) {
            __syncthreads();
            if (F.tid == 0) F.MISC[0] = __hip_atomic_fetch_add(qhead + 64, 1u, RLX_AGENT);
            __syncthreads();
            const unsigned u = F.MISC[0];
            if (u >= (unsigned)TQ_UNITS) break;
            quant_tables_unit(F, args, (int)u);
        }
        if (BOTH(2)) xcd_barrier(bar);
    }
    if (IN(3)) for (int rep = 0; rep < probe_rep[3]; ++rep) {
        pg8::Gemm g{(const bf16*)args.out, (const bf16*)(ws + WS_WAT), M, D, 2 * D, D, PROJ + C_HMN, LDP, D}; pg8::StaticOrder S; S.init(M, D, F.G, (int)blockIdx.x);
        pg8::EpiMixDual E{PROJ + C_MIX, (const unsigned char*)(PROJ + (size_t)M * LDP)};
        pg8::gemm_phase_dual<pg8::EpiMixDual, pg8::StaticOrder, true, true>(F.lds + RING_OFF, g, S, E);
        if (BOTH(3)) xcd_barrier(bar);
    }
    if (IN(5)) for (int rep = 0; rep < probe_rep[5]; ++rep) {
        pg8::Gemm g{PROJ + C_MIX, (const bf16*)(ws + WS_WOT), M, D, D / 2, LDP, nullptr, 0, D / 2}; pg8::StaticOrder S; S.init(M, D, F.G, (int)blockIdx.x);
        pg8::EpiX1 E{(const float*)args.in[0], PROJ + C_X1B, (float*)(ws + WS_SSQ), (const float*)(F.ctl + CW_SWMAX + NP + D)};
        pg8::gemm_phase_i8<pg8::EpiX1, pg8::StaticOrder, true, true>(F.lds + RING_OFF, g, S, E);
        if (BOTH(5)) xcd_barrier(bar);
    }
    if (IN(6)) for (int rep = 0; rep < probe_rep[6]; ++rep) {
        { const int gw = blockIdx.x * NWAVES + F.wave, NGW = F.G * NWAVES;
          QRow qn = quantize_load(PROJ, (const float*)(ws + WS_SSQ), gw < M ? gw : 0, F.lane);
#pragma unroll 1
          for (int t = gw; t < M; t += NGW) { const QRow qc = qn; qn = quantize_load(PROJ, (const float*)(ws + WS_SSQ), (t + NGW < M) ? t + NGW : t, F.lane); quantize_row(qc, PROJ, (float*)(ws + WS_GATES), t, F.lane); } }
        xcd_barrier(bar);
        pg8::Gemm g{PROJ + C_XQ, (const bf16*)(ws + WS_WQT), M, D, D / 2, LDP, nullptr, 0, D / 2}; pg8::StaticOrder S; S.init(M, D, F.G, (int)blockIdx.x);
        pg8::EpiQ E{PROJ + C_QB, (const float*)(ws + WS_GATES), (const float*)(F.ctl + CW_SWMAX + NP)};
        pg8::gemm_phase_i8<pg8::EpiQ, pg8::StaticOrder, true, true>(F.lds + RING_OFF, g, S, E);
        if (BOTH(6)) xcd_barrier(bar);
    }
    if (IN(7)) for (int rep = 0; rep < probe_rep[7]; ++rep) {
        const int gw = blockIdx.x * NWAVES + F.wave, NGW = F.G * NWAVES;
        { const bf16* KEYS = (const bf16*)(ws + WS_KEYS);
#pragma unroll 1
          for (int h = 0; h < 8; ++h) {
              const int ln = (int)__builtin_amdgcn_mbcnt_hi(~0u, __builtin_amdgcn_mbcnt_lo(~0u, 0u));
              __syncthreads();
              for (int i = F.wave * 64 + ln; i < 2 * 128 * 8; i += NTHREADS) { const int row = i >> 3, pc = i & 7; *(LAS v4u*)(F.lds + RT_KEYS_OFF + row * RT_KROW + 16 * pc) = *(const v4u*)(KEYS + (size_t)h * 2 * 128 * 64 + (size_t)row * 64 + 8 * pc); }
              __syncthreads();
#pragma unroll 1
              for (int tt = gw; tt < M / 32; tt += NGW) { RouteQ qc; route_load_q(qc, PROJ, tt, h, ln); route_unit(F, qc, (int*)(ws + WS_IDX), (float*)(ws + WS_GATE), tt, h); }
          } }
        if (BOTH(7)) xcd_barrier(bar);
    }
    if (IN(8)) {
        if (F.tid == 0) {
            int npop = 0, mypos = 0, nloc = 1;
            for (int j = 0; j < 16; ++j) { const unsigned cnt = xb_ld((unsigned*)(F.ctl + CW_BAR) + XB_XCNT(j)); if (cnt) { if (j == (int)bar.x) { mypos = npop; nloc = (int)cnt; } ++npop; } }
            F.MISC[2] = (unsigned)npop; F.MISC[3] = (unsigned)mypos; F.MISC[4] = (unsigned)nloc;
        }
        __syncthreads();
        const int npop = (int)F.MISC[2], mypos = (int)F.MISC[3], nloc = (int)F.MISC[4], rank = (int)F.MISC[1];
        const int w0 = rank * NWAVES + F.wave, nw = nloc * NWAVES;
        for (int p = mypos; p < 8; p += npop)
            peer_down_phase(F, PROJ, (const float*)(ws + WS_GATES), (const unsigned*)(ws + WS_IDX), (unsigned*)(ws + WS_COEF), (const unsigned char*)(ws + WS_DOWN), (const float*)(ws + WS_SCD), (const float*)(ws + WS_SCU), p, w0, nw);
        xcd_barrier(bar);
        for (int p = mypos; p < 8; p += npop)
            peer_up_phase(F, (const unsigned*)(ws + WS_COEF), (const unsigned char*)(ws + WS_UP), PROJ, args.out, p, w0, nw);
    }
#undef IN
#undef BOTH
}

extern "C" void kernel_launch(void* const* d_in, const int* in_sizes, int n_in, void* d_out, int out_size, void* d_ws, size_t ws_size, hipStream_t stream) {
    static int grid = 0;
    if (grid == 0) {
        if (n_in != 18 || out_size != M * D || ws_size < WS_END) { fprintf(stderr, "kernel_launch: unexpected sizes (n_in %d out %d ws %zu)\n", n_in, out_size, ws_size); grid = -1; return; }
        int dev = 0, cus = 0, per_cu = 0;
        (void)hipGetDevice(&dev); (void)hipDeviceGetAttribute(&cus, hipDeviceAttributeMultiprocessorCount, dev);
        (void)hipFuncSetAttribute((const void*)mega, hipFuncAttributeMaxDynamicSharedMemorySize, LDS_BYTES);
        (void)hipOccupancyMaxActiveBlocksPerMultiprocessor(&per_cu, (const void*)mega, NTHREADS, LDS_BYTES);
        if (per_cu < 1) fprintf(stderr, "kernel_launch: occupancy query says %d\n", per_cu);
        (void)hipGetLastError();
        grid = cus;
    }
    if (grid < 0) return;
    unsigned char* ws = (unsigned char*)d_ws;
    float* out = (float*)d_out;
    bf16* PROJ = (bf16*)(ws + WS_PROJ);
    (void)hipMemsetAsync(ws + WS_CTL, 0, CTL_ZERO_BYTES, stream);
    Args a{};
    for (int i = 0; i < 18; ++i) a.in[i] = d_in[i];
    a.out = out; a.ws = ws;
    a.ph_lo = 0; a.ph_hi = 9;
    hipLaunchKernelGGL(mega, dim3(grid), dim3(NTHREADS), LDS_BYTES, stream, a);
}
```
